# Optimizing an MI355X kernel written in HIP

```python
import math
import jax, jax.numpy as jnp
from jax import lax
import numpy as np

D_MODEL = 4096
BATCH = 2
SEQ = 4096
DEPTH = 2

HEAD_DIM = 128
A_HEADS = 8
A_WIDTH = A_HEADS * HEAD_DIM
A_SUB = HEAD_DIM // 2
B_GROUPS = ((128, 1), (512, 4), (2048, 16))
B_HEADS_PER_GROUP = 3
B_HEADS = B_HEADS_PER_GROUP * len(B_GROUPS)
B_WIDTH = B_HEADS * HEAD_DIM
C_WINDOWS = (2, 4, 8, 16)
C_GROUPS = len(C_WINDOWS)
C_WIDTH = 1024
C_GROUP_DIM = C_WIDTH // C_GROUPS
D_WIDTH = D_MODEL - A_WIDTH - B_WIDTH - C_WIDTH
CONV_WIDTH = 3
IN_SIZES = (A_WIDTH, A_WIDTH, A_WIDTH, B_WIDTH, B_WIDTH, B_WIDTH, C_WIDTH, D_WIDTH, D_WIDTH, D_WIDTH)
IN_WIDTH = sum(IN_SIZES)
IN_SPLITS = [int(v) for v in np.cumsum(IN_SIZES)[:-1]]
D_FF = 4 * D_MODEL
ROPE_THETA = 10000.0
Q_BLOCK = 128
NORM_EPS = 1e-6
DIFF_EPS = 1e-5

kernel_name = "hybrid_parallel_heads_diffattn_dilated_pool_shortconv"


def rms_norm(x, g, eps=NORM_EPS):
    xf = x.astype(jnp.float32)
    y = xf * lax.rsqrt(jnp.mean(xf * xf, axis=-1, keepdims=True) + eps)
    return (y * g.astype(jnp.float32)).astype(x.dtype)


def rope_tables(seq, dim):
    inv = ROPE_THETA ** (-jnp.arange(0, dim, 2, dtype=jnp.float32) / dim)
    ang = jnp.arange(seq, dtype=jnp.float32)[:, None] * inv[None, :]
    return jnp.cos(ang), jnp.sin(ang)


def apply_rope(x, cos, sin):
    shape = (1, x.shape[1]) + (1,) * (x.ndim - 3) + (cos.shape[-1],)
    c = cos.reshape(shape)
    s = sin.reshape(shape)
    xf = x.astype(jnp.float32)
    x1, x2 = jnp.split(xf, 2, axis=-1)
    out = jnp.concatenate([x1 * c - x2 * s, x1 * s + x2 * c], axis=-1)
    return out.astype(x.dtype)


def diff_attention(q, k, v, lam, subln_g, lam_init):
    b, s, h = q.shape[:3]
    nb = s // Q_BLOCK
    scale = A_SUB ** -0.5
    qb = q.reshape(b, nb, Q_BLOCK, h, 2, A_SUB).swapaxes(0, 1)
    kpos = jnp.arange(s)

    def block(args):
        qi, start = args
        sc = jnp.einsum('bqhcd,bkhcd->bchqk', qi, k, preferred_element_type=jnp.float32) * scale
        qpos = start + jnp.arange(Q_BLOCK)
        mask = qpos[:, None] >= kpos[None, :]
        p = jax.nn.softmax(jnp.where(mask, sc, -jnp.inf), axis=-1)
        w = p[:, 0] - lam * p[:, 1]
        return jnp.einsum('bhqk,bkhd->bqhd', w.astype(v.dtype), v)

    o = lax.map(block, (qb, jnp.arange(nb) * Q_BLOCK))
    o = o.swapaxes(0, 1).reshape(b, s, h, HEAD_DIM)
    o = rms_norm(o, subln_g, DIFF_EPS) * (1.0 - lam_init)
    return o.reshape(b, s, h * HEAD_DIM)


def dilated_group_attention(q, k, v, window, dilation):
    b, s, h, dh = q.shape
    n_keys = window // dilation + 1
    nb = s // Q_BLOCK
    offs = dilation * jnp.arange(n_keys)
    scale = dh ** -0.5
    qb = q.reshape(b, nb, Q_BLOCK, h, dh).swapaxes(0, 1)

    def block(args):
        qi, start = args
        idx = (start + jnp.arange(Q_BLOCK))[:, None] - offs[None, :]
        valid = idx >= 0
        idxc = jnp.maximum(idx, 0)
        kg = k[:, idxc]
        vg = v[:, idxc]
        sc = jnp.einsum('bqhd,bqjhd->bhqj', qi, kg, preferred_element_type=jnp.float32) * scale
        sc = jnp.where(valid[None, None], sc, -jnp.inf)
        lse = jax.nn.logsumexp(sc, axis=-1, keepdims=True)
        p = jnp.exp(sc - lse)
        o = jnp.einsum('bhqj,bqjhd->bqhd', p.astype(v.dtype), vg)
        return o, lse[..., 0].transpose(0, 2, 1)

    o, lse = lax.map(block, (qb, jnp.arange(nb) * Q_BLOCK))
    o = o.swapaxes(0, 1).reshape(b, s, h, dh)
    lse = lse.swapaxes(0, 1).reshape(b, s, h)
    return o, lse


def dilated_mixture(q, k, v):
    b, s = q.shape[:2]
    n_g = len(B_GROUPS)
    q = q.reshape(b, s, n_g, B_HEADS_PER_GROUP, HEAD_DIM)
    k = k.reshape(b, s, n_g, B_HEADS_PER_GROUP, HEAD_DIM)
    v = v.reshape(b, s, n_g, B_HEADS_PER_GROUP, HEAD_DIM)
    outs, lses = [], []
    for g, (window, dilation) in enumerate(B_GROUPS):
        o, l = dilated_group_attention(q[:, :, g], k[:, :, g], v[:, :, g], window, dilation)
        outs.append(o)
        lses.append(l)
    o = jnp.stack(outs, axis=2)
    alpha = jax.nn.softmax(jnp.stack(lses, axis=2), axis=2)
    o = (o.astype(jnp.float32) * alpha[..., None]).astype(q.dtype)
    return o.reshape(b, s, B_WIDTH)


def multiscale_pool(u, pool_w, pool_scale):
    b, s, _ = u.shape
    uf = u.astype(jnp.float32).reshape(b, s, C_GROUPS, C_GROUP_DIM)
    cs = jnp.concatenate([jnp.zeros((b, 1, C_GROUPS, C_GROUP_DIM), jnp.float32),
                          jnp.cumsum(uf, axis=1)], axis=1)
    t = jnp.arange(s)[:, None]
    win = jnp.array(C_WINDOWS, dtype=jnp.int32)[None, :]
    lo = jnp.maximum(t + 1 - win, 0)
    cnt = jnp.minimum(t + 1, win).astype(jnp.float32)
    gidx = jnp.arange(C_GROUPS)[None, :]
    mean = (cs[:, 1:] - cs[:, lo, gidx]) / cnt[None, :, :, None]
    pooled = mean - uf
    y = jnp.einsum('bsgc,gcd->bsgd', pooled, pool_w.astype(jnp.float32))
    y = y.reshape(b, s, C_WIDTH) * pool_scale.astype(jnp.float32)
    return y.astype(u.dtype)


def short_conv_mixer(gate_b, gate_c, hx, conv_w):
    z = gate_c * hx
    y = lax.conv_general_dilated(z, conv_w[:, None, :].astype(z.dtype), window_strides=(1,),
                                 padding=[(CONV_WIDTH - 1, 0)],
                                 dimension_numbers=('NWC', 'WIO', 'NWC'),
                                 feature_group_count=z.shape[-1])
    return gate_b * y


def setup_inputs(seed: int = 0) -> dict:
    key = jax.random.key(seed)
    ks = jax.random.split(key, 14)
    f32 = jnp.float32
    nrm = lambda k, shape, sc: jax.random.normal(k, shape, f32) * sc
    return {
        "x": nrm(ks[0], (BATCH, SEQ, D_MODEL), 1.0),
        "w_in": nrm(ks[1], (DEPTH, D_MODEL, IN_WIDTH), D_MODEL ** -0.5),
        "w_out": nrm(ks[2], (DEPTH, D_MODEL, D_MODEL), D_MODEL ** -0.5),
        "norm_mix": 1.0 + nrm(ks[3], (DEPTH, D_MODEL), 0.02),
        "norm_mlp": 1.0 + nrm(ks[4], (DEPTH, D_MODEL), 0.02),
        "diff_lambda": nrm(ks[5], (DEPTH, 4, A_SUB), 0.1),
        "diff_subln": 1.0 + nrm(ks[6], (DEPTH, HEAD_DIM), 0.02),
        "pool_w": nrm(ks[7], (DEPTH, C_GROUPS, C_GROUP_DIM, C_GROUP_DIM), C_GROUP_DIM ** -0.5),
        "pool_scale": 1.0 + nrm(ks[8], (DEPTH, C_WIDTH), 0.1),
        "conv_w": nrm(ks[9], (DEPTH, CONV_WIDTH, D_WIDTH), CONV_WIDTH ** -0.5),
        "w_up": nrm(ks[10], (DEPTH, D_MODEL, D_FF), D_MODEL ** -0.5),
        "w_down": nrm(ks[11], (DEPTH, D_FF, D_MODEL), D_FF ** -0.5),
        "norm_final": 1.0 + nrm(ks[12], (D_MODEL,), 0.02),
    }


def reference(x, w_in, w_out, norm_mix, norm_mlp, diff_lambda, diff_subln, pool_w, pool_scale,
              conv_w, w_up, w_down, norm_final):
    b, s, _ = x.shape
    cos_a, sin_a = rope_tables(s, A_SUB)
    cos_b, sin_b = rope_tables(s, HEAD_DIM)
    for l in range(DEPTH):
        h = rms_norm(x, norm_mix[l])
        proj = jnp.einsum('bsd,de->bse', h, w_in[l])
        qa, ka, va, qb, kb, vb, u, gate_b, gate_c, hd = jnp.split(proj, IN_SPLITS, axis=-1)

        lam_init = 0.8 - 0.6 * math.exp(-0.3 * l)
        lp = diff_lambda[l].astype(jnp.float32)
        lam = jnp.exp(jnp.sum(lp[0] * lp[1])) - jnp.exp(jnp.sum(lp[2] * lp[3])) + lam_init
        qa = apply_rope(qa.reshape(b, s, A_HEADS, 2, A_SUB), cos_a, sin_a)
        ka = apply_rope(ka.reshape(b, s, A_HEADS, 2, A_SUB), cos_a, sin_a)
        va = va.reshape(b, s, A_HEADS, HEAD_DIM)
        out_a = diff_attention(qa, ka, va, lam, diff_subln[l], lam_init)

        qb = apply_rope(qb.reshape(b, s, B_HEADS, HEAD_DIM), cos_b, sin_b)
        kb = apply_rope(kb.reshape(b, s, B_HEADS, HEAD_DIM), cos_b, sin_b)
        vb = vb.reshape(b, s, B_HEADS, HEAD_DIM)
        out_b = dilated_mixture(qb, kb, vb)

        out_c = multiscale_pool(u, pool_w[l], pool_scale[l])

        out_d = short_conv_mixer(gate_b, gate_c, hd, conv_w[l])

        mix = jnp.concatenate([out_a, out_b, out_c, out_d], axis=-1)
        x = x + jnp.einsum('bse,ed->bsd', mix, w_out[l])

        h = rms_norm(x, norm_mlp[l])
        act = jnp.square(jax.nn.relu(jnp.einsum('bsd,df->bsf', h, w_up[l])))
        x = x + jnp.einsum('bsf,fd->bsd', act, w_down[l])
    return rms_norm(x, norm_final)
```

```cpp
#include <hip/hip_runtime.h>
#include <hip/hip_bf16.h>
#include <cstdio>
#include <cstdint>
#include <cmath>

constexpr int BATCH = 2, SEQ = 4096, DM = 4096, M = BATCH * SEQ, NIN = 10240, DFF = 16384, DEPTH = 2;
constexpr int C_QA = 0, C_KA = 1024, C_VA = 2048, C_QB = 3072, C_KB = 4224, C_VB = 5376, C_U = 6528, C_GB = 7552, C_GC = 8448, C_HD = 9344;
constexpr int LDH = DM, LDP = NIN, LDMX = DM, LDOC = 2048, LDACT = DFF;
constexpr int MIX_A = 0, MIX_B = 1024, MIX_C = 2176, MIX_D = 3200;
constexpr float LOG2E = 1.4426950408889634f;
constexpr float SC_A = 0.125f * LOG2E;
constexpr float SC_B = 0.08838834764831845f * LOG2E;

namespace pg8 {
#define PG8_LAS __attribute__((address_space(3)))
typedef unsigned short bf16_t;
typedef short bf16x8 __attribute__((ext_vector_type(8)));
typedef float f32x4 __attribute__((ext_vector_type(4)));
typedef float f32x2 __attribute__((ext_vector_type(2)));
typedef unsigned u32x4 __attribute__((ext_vector_type(4)));
typedef unsigned long long ss_t;
constexpr float SS_SCALE = 16777216.f, SS_INV = 1.f / 16777216.f;
constexpr int BM = 256, BK = 64, HALF = 128, HTB = HALF * BK * 2  , STAGE_BYTES = 8 * HTB, NXCD = 8, WGM = 4;

__host__ __device__ __forceinline__ int lds_byte(int r, int c) { const int st = (r >> 4) * 2 + (c >> 5), rr = r & 15, cc = c & 31, ob = rr * 64 + cc * 2; return st * 1024 + (ob ^ (((ob >> 9) & 1) << 5)); }
__host__ __device__ __forceinline__ void stage_rc(int b, int& R, int& C) { const int st = b / 1024, sb = b % 1024, swz = sb ^ (((sb >> 9) & 1) << 5); R = (st >> 1) * 16 + swz / 64; C = (st & 1) * 32 + (swz % 64) / 2; }
__host__ __device__ __forceinline__ int perm32(int rho) { const int n = rho >> 4, i = rho & 15; return 8 * (i >> 2) + 4 * n + (i & 3); }

__host__ __device__ __forceinline__ size_t img_elem(int r, int c, int K) { const int ob = (r & 15) * 64 + (c & 31) * 2; return ((size_t)((r >> 4) * (K >> 5) + (c >> 5)) * 1024 + (size_t)(ob ^ (((ob >> 9) & 1) << 5))) >> 1; }
__host__ __device__ __forceinline__ int p32inv(int s) { return 16 * ((s >> 2) & 1) + 4 * (s >> 3) + (s & 3); }
__host__ __device__ __forceinline__ int brow(int np) { return (np & ~31) + p32inv(np & 31); }
__device__ __forceinline__ unsigned epi_img_base(int pm, int pn, int wr, int wc, int fr, int fq, int K) {
    return (unsigned)((16 * pm + 4 * wr) * (K >> 5) + 8 * pn + wc) * 512u + (unsigned)(fr * 64 + ((16 * fq) ^ ((fr & 8) << 2))) / 2u; }
struct Unit { int pm, pn; };
struct Gemm { const bf16_t* A; const bf16_t* Bt; int M, N, K, lda; size_t b_pm_stride; };

struct StaticOrder {
    int nM, nN, nwg, G, c;
    __host__ __device__ void init(int M_, int N_, int G_, int c_) { nM = M_ / BM; nN = N_ / BM; nwg = nM * nN; G = G_; c = c_; }
    __host__ __device__ bool next(int i, Unit& u) const {
        const long L = (long)i * G + c; if (L >= nwg) return false;
        int wgid = (int)L; { const int q = nwg / NXCD, r = nwg % NXCD, xcd = wgid % NXCD, off = wgid / NXCD; wgid = (xcd < r ? xcd * (q + 1) : r * (q + 1) + (xcd - r) * q) + off; }
        const int nig = WGM * nN, gid = wgid / nig, fm = gid * WGM, gsz = (nM - fm) < WGM ? (nM - fm) : WGM;
        u.pm = fm + ((wgid % nig) % gsz); u.pn = (wgid % nig) / gsz; return true;
    }
};

typedef __bf16 bf16x2_t __attribute__((ext_vector_type(2)));
__device__ __forceinline__ unsigned cvt_pk_bf16(float lo, float hi) { f32x2 v = {lo, hi}; bf16x2_t b = __builtin_convertvector(v, bf16x2_t); return __builtin_bit_cast(unsigned, b); }
__device__ __forceinline__ u32x4 pack8(const f32x4& a, const f32x4& b) { u32x4 w; w.x = cvt_pk_bf16(a[0], a[1]); w.y = cvt_pk_bf16(a[2], a[3]); w.z = cvt_pk_bf16(b[0], b[1]); w.w = cvt_pk_bf16(b[2], b[3]); return w; }

struct EpiProj {
    static constexpr bool PERM = true;
    bf16_t* O; const float* cosA; const float* sinA; const float* cosB; const float* sinB; const ss_t* ss;
    __device__ __forceinline__ void operator()(const f32x4 (&acc)[2][2][4][2], const Unit& u, int wr, int wc, int fr, int fq) const {
        const int pn = u.pn, row0 = u.pm * BM + wr * 64 + fr;
        float rs[2][4];
#pragma unroll
        for (int ai = 0; ai < 2; ++ai)
#pragma unroll
            for (int m = 0; m < 4; ++m) rs[ai][m] = 1.f / sqrtf((float)ss[row0 + ai * HALF + m * 16] * (SS_INV / DM) + 1e-6f);
        const int type = pn < 8 ? 1 : ((pn >= 12 && pn <= 20) ? 2 : 0);
        if (type == 0) {
            const int col0 = pn * BM + wc * 32 + 8 * fq;
#pragma unroll
            for (int ai = 0; ai < 2; ++ai)
#pragma unroll
                for (int m = 0; m < 4; ++m) { bf16_t* rowp = O + (size_t)(row0 + ai * HALF + m * 16) * LDP + col0;
#pragma unroll
                    for (int bj = 0; bj < 2; ++bj) *(u32x4*)(rowp + bj * HALF) = pack8(acc[ai][bj][m][0] * rs[ai][m], acc[ai][bj][m][1] * rs[ai][m]); }
        } else {
            float sc; int i0, d1, dd, tp; const float *ct, *st;
            if (type == 1) { sc = pn < 4 ? SC_A : 1.f; i0 = 8 * fq; d1 = pn * BM + 64 * wc + i0; dd = 32; tp = 32; ct = cosA; st = sinA; }
            else { const bool isq = (pn < 16) || (pn == 16 && wc < 2); sc = isq ? SC_B : 1.f; i0 = 32 * (wc & 1) + 8 * fq; d1 = pn * BM + 128 * (wc >> 1) + i0; dd = 64; tp = 64; ct = cosB; st = sinB; }
#pragma unroll
            for (int ai = 0; ai < 2; ++ai)
#pragma unroll
                for (int m = 0; m < 4; ++m) { const int row = row0 + ai * HALF + m * 16, pos = row & (SEQ - 1); const float scr = sc * rs[ai][m];
                    const f32x4 c0 = *(const f32x4*)(ct + pos * tp + i0), c1 = *(const f32x4*)(ct + pos * tp + i0 + 4), s0 = *(const f32x4*)(st + pos * tp + i0), s1 = *(const f32x4*)(st + pos * tp + i0 + 4);
                    const f32x4 x10 = acc[ai][0][m][0], x11 = acc[ai][0][m][1], x20 = acc[ai][1][m][0], x21 = acc[ai][1][m][1];
                    const f32x4 a0 = (x10 * c0 - x20 * s0) * scr, a1 = (x11 * c1 - x21 * s1) * scr, b0 = (x10 * s0 + x20 * c0) * scr, b1 = (x11 * s1 + x21 * c1) * scr;
                    bf16_t* rowp = O + (size_t)row * LDP + d1;
                    *(u32x4*)(rowp) = pack8(a0, a1); *(u32x4*)(rowp + dd) = pack8(b0, b1); }
        }
    }
};
struct EpiRelu2 {
    static constexpr bool PERM = true;
    bf16_t* O; int Kact; const ss_t* ss;
    __device__ __forceinline__ void operator()(const f32x4 (&acc)[2][2][4][2], const Unit& u, int wr, int wc, int fr, int fq) const {
        const int row0 = u.pm * BM + wr * 64 + fr; const unsigned base = epi_img_base(u.pm, u.pn, wr, wc, fr, fq, Kact); const unsigned kb = (unsigned)(Kact >> 5) * 512u;
#pragma unroll
        for (int ai = 0; ai < 2; ++ai)
#pragma unroll
            for (int m = 0; m < 4; ++m) { const float r2 = 1.f / ((float)ss[row0 + ai * HALF + m * 16] * (SS_INV / DM) + 1e-6f);
#pragma unroll
                for (int bj = 0; bj < 2; ++bj) { f32x4 v0 = acc[ai][bj][m][0], v1 = acc[ai][bj][m][1];
                    v0 = __builtin_elementwise_max(v0, (f32x4){0.f, 0.f, 0.f, 0.f}); v1 = __builtin_elementwise_max(v1, (f32x4){0.f, 0.f, 0.f, 0.f}); v0 = v0 * v0 * r2; v1 = v1 * v1 * r2;
                    *(u32x4*)(O + (size_t)(base + (unsigned)(8 * ai + m) * kb + (unsigned)(4 * bj) * 512u)) = pack8(v0, v1); } }
    }
};
struct EpiRes {
    static constexpr bool PERM = true;
    bf16_t* xb; int ldh; ss_t* ss; float* outf; int ldc;
    __device__ __forceinline__ void operator()(const f32x4 (&acc)[2][2][4][2], const Unit& u, int wr, int wc, int fr, int fq) const {
        const int row0 = u.pm * BM + wr * 64 + fr, col0 = u.pn * BM + wc * 32 + 8 * fq; const bool LAST = outf != nullptr; const unsigned base = epi_img_base(u.pm, u.pn, wr, wc, fr, fq, DM);
#pragma unroll
        for (int ai = 0; ai < 2; ++ai)
#pragma unroll
            for (int m = 0; m < 4; ++m) { const int row = row0 + ai * HALF + m * 16; float sq = 0.f;
#pragma unroll
                for (int bj = 0; bj < 2; ++bj) { bf16_t* xp = xb + (size_t)(base + (unsigned)(8 * ai + m) * (unsigned)(DM / 32) * 512u + (unsigned)(4 * bj) * 512u); const u32x4 w = *(const u32x4*)xp;
                    const f32x4 r0 = {__uint_as_float(w.x << 16), __uint_as_float(w.x & 0xffff0000u), __uint_as_float(w.y << 16), __uint_as_float(w.y & 0xffff0000u)};
                    const f32x4 r1 = {__uint_as_float(w.z << 16), __uint_as_float(w.z & 0xffff0000u), __uint_as_float(w.w << 16), __uint_as_float(w.w & 0xffff0000u)};
                    const f32x4 x0 = r0 + acc[ai][bj][m][0], x1 = r1 + acc[ai][bj][m][1];
                    if (LAST) { float* op = outf + (size_t)row * ldc + col0 + bj * HALF; *(f32x4*)op = x0; *(f32x4*)(op + 4) = x1; }
                    else { *(u32x4*)xp = pack8(x0, x1);
                        sq += (x0[0] * x0[0] + x0[1] * x0[1]) + (x0[2] * x0[2] + x0[3] * x0[3]) + (x1[0] * x1[0] + x1[1] * x1[1]) + (x1[2] * x1[2] + x1[3] * x1[3]); } }
                if (!LAST) { sq += __shfl_xor(sq, 16); sq += __shfl_xor(sq, 32); if (fq == 0) atomicAdd(ss + row, (ss_t)(sq * SS_SCALE)); } }
    }
};
struct EpiFold {
    static constexpr bool PERM = true;
    bf16_t* W0; size_t layer_stride;
    __device__ __forceinline__ void operator()(const f32x4 (&acc)[2][2][4][2], const Unit& u, int wr, int wc, int fr, int fq) const {
        bf16_t* W = W0 + (size_t)(u.pm >> 2) * layer_stride; const int n0 = C_U + (u.pm & 3) * 256 + wr * 64;
        const unsigned rb0 = (unsigned)(n0 >> 4) + ((fr >> 2) & 1), rl = 4 * (fr >> 3) + (fr & 3), cb0 = (unsigned)(u.pn * 8 + wc);
        const unsigned base_e = (rb0 * (DM / 32) + cb0) * 512u + (rl * 64u + 16u * fq) / 2u, base_o = (rb0 * (DM / 32) + cb0) * 512u + ((rl + 8u) * 64u + 16u * (fq ^ 2)) / 2u;
#pragma unroll
        for (int ai = 0; ai < 2; ++ai)
#pragma unroll
            for (int m = 0; m < 4; ++m)
#pragma unroll
                for (int bj = 0; bj < 2; ++bj) { const unsigned off = ((m & 1) ? base_o : base_e) + (unsigned)((8 * ai + 2 * (m >> 1)) * (DM / 32) + 4 * bj) * 512u;
                    *(u32x4*)(W + off) = pack8(acc[ai][bj][m][0], acc[ai][bj][m][1]); }
    }
};

template <class Epi, class Sched, bool ALIGN_EPI, int LMASK = -1, int LMASKB = LMASK>
__device__ __forceinline__ void gemm_phase(PG8_LAS unsigned char* lds, const Gemm g, const Sched& S, const Epi& E) {
    int tid = threadIdx.x; asm volatile("" : "+v"(tid));
    const int wid = __builtin_amdgcn_readfirstlane(tid >> 6), lane = tid & 63, wr = wid >> 2, wc = wid & 3, fr = lane & 15, fq = lane >> 4;
    const int K = g.K, nt = K / BK;
    unsigned voffA[2], voffB[2];
#pragma unroll
    for (int i = 0; i < 2; ++i) { int R, C; stage_rc(tid * 16 + i * 8192, R, C); const int Rb = Epi::PERM ? ((R & ~31) + perm32(R & 31)) : R;
        voffB[i] = (unsigned)(((R >> 4) * (K / 32) + (C >> 5)) * 1024 + ((tid * 16) & 1023)); voffA[i] = voffB[i]; (void)Rb; }
    const size_t kstepA = (size_t)2048, hstepA = (size_t)HALF * K * 2, tstepA = 2 * hstepA;
    const size_t kstepB = (size_t)2048, hstepB = (size_t)HALF * K * 2, tstepB = 2 * hstepB;
    const unsigned ldsw = (unsigned)wid * 1024u;
    const int aoff = lds_byte(wr * 64 + fr, fq * 8), boff = lds_byte(wc * 32 + fr, fq * 8);
#define PG8_SA(b, h) (((b) * 2 + (h)) * HTB)
#define PG8_SB(b, h) ((4 + (b) * 2 + (h)) * HTB)
#define PG8_STAGE(bufoff, gbase, voff) do { _Pragma("unroll") for (int _i = 0; _i < 2; ++_i) \
        __builtin_amdgcn_global_load_lds((const unsigned*)((const char*)(gbase) + (voff)[_i]), (PG8_LAS unsigned*)(lds + (bufoff) + ldsw + _i * 8192), 16, 0, 0); } while (0)
#define PG8_LDA(dst, b, h) do { _Pragma("unroll") for (int m = 0; m < 4; ++m) _Pragma("unroll") for (int k = 0; k < 2; ++k) dst[m][k] = *(const PG8_LAS bf16x8*)(lds + PG8_SA(b, h) + aoff + m * 2048 + k * 1024); } while (0)
#define PG8_LDB(dst, b, h) do { _Pragma("unroll") for (int n = 0; n < 2; ++n) _Pragma("unroll") for (int k = 0; k < 2; ++k) dst[n][k] = *(const PG8_LAS bf16x8*)(lds + PG8_SB(b, h) + boff + n * 2048 + k * 1024); } while (0)
#define PG8_MMA(ai, bj, At, Bt) do { __builtin_amdgcn_s_setprio(1); _Pragma("unroll") for (int m = 0; m < 4; ++m) _Pragma("unroll") for (int n = 0; n < 2; ++n) _Pragma("unroll") for (int k = 0; k < 2; ++k) \
        acc[ai][bj][m][n] = __builtin_amdgcn_mfma_f32_16x16x32_bf16(Bt[n][k], At[m][k], acc[ai][bj][m][n], 0, 0, 0); __builtin_amdgcn_s_setprio(0); } while (0)
#define PG8_WAIT_V(n) asm volatile("s_waitcnt vmcnt(" #n ")" ::: "memory")
#define PG8_WAIT_L(n) asm volatile("s_waitcnt lgkmcnt(" #n ")" ::: "memory")
#define PG8_BAR __builtin_amdgcn_s_barrier()
#define PG8_SCHED __builtin_amdgcn_sched_barrier(0)
    Unit cur, nxt; int ui = 0;
    if (!S.next(0, cur)) return;
    f32x4 acc[2][2][4][2];
#pragma unroll
    for (int a = 0; a < 2; ++a)
#pragma unroll
        for (int b = 0; b < 2; ++b)
#pragma unroll
            for (int m = 0; m < 4; ++m)
#pragma unroll
                for (int n = 0; n < 2; ++n) acc[a][b][m][n] = (f32x4){0.f, 0.f, 0.f, 0.f};
    bf16x8 At[4][2], B0[2][2], B1[2][2];
    const char* cA = (const char*)g.A + (size_t)(cur.pm & LMASK) * tstepA; const char* cB = (const char*)g.Bt + (size_t)cur.pm * g.b_pm_stride + (size_t)(cur.pn & LMASKB) * tstepB;
    PG8_STAGE(PG8_SB(0, 0), cB, voffB); PG8_STAGE(PG8_SB(0, 1), cB + hstepB, voffB); PG8_STAGE(PG8_SA(0, 0), cA, voffA); PG8_STAGE(PG8_SA(0, 1), cA + hstepA, voffA);
    if (wr == 1) PG8_BAR;
    PG8_WAIT_V(2); PG8_BAR;
    PG8_STAGE(PG8_SB(1, 0), cB + kstepB, voffB); PG8_STAGE(PG8_SA(1, 0), cA + kstepA, voffA); PG8_STAGE(PG8_SB(1, 1), cB + hstepB + kstepB, voffB);
    PG8_WAIT_V(6); PG8_BAR;
    for (;;) {
        const bool has_next = S.next(ui + 1, nxt);
        const char* nA = has_next ? (const char*)g.A + (size_t)(nxt.pm & LMASK) * tstepA : cA; const char* nB = has_next ? (const char*)g.Bt + (size_t)nxt.pm * g.b_pm_stride + (size_t)(nxt.pn & LMASKB) * tstepB : cB;
        for (int t = 0; t < nt; t += 2) {
            const bool last = (t == nt - 2);
            const char* a1 = cA + (size_t)(t + 1) * kstepA;
            const char* a2 = last ? nA : cA + (size_t)(t + 2) * kstepA; const char* b2 = last ? nB : cB + (size_t)(t + 2) * kstepB;
            const char* a3 = a2 + kstepA; const char* b3 = b2 + kstepB;
            PG8_LDB(B0, 0, 0); PG8_LDB(B1, 0, 1); PG8_SCHED; PG8_LDA(At, 0, 0); PG8_STAGE(PG8_SA(1, 1), a1 + hstepA, voffA);
            PG8_WAIT_V(8); PG8_WAIT_L(0); PG8_BAR; PG8_MMA(0, 0, At, B0); PG8_MMA(0, 1, At, B1); PG8_BAR; PG8_SCHED;
            PG8_LDA(At, 0, 1); PG8_STAGE(PG8_SB(0, 0), b2, voffB); PG8_STAGE(PG8_SB(0, 1), b2 + hstepB, voffB); PG8_STAGE(PG8_SA(0, 0), a2, voffA);
            PG8_WAIT_V(8); PG8_WAIT_L(0); PG8_BAR; PG8_MMA(1, 0, At, B0); PG8_MMA(1, 1, At, B1); PG8_BAR; PG8_SCHED;
            PG8_LDB(B0, 1, 0); PG8_LDB(B1, 1, 1); PG8_SCHED; PG8_LDA(At, 1, 0); PG8_STAGE(PG8_SA(0, 1), a2 + hstepA, voffA);
            PG8_WAIT_V(8); PG8_WAIT_L(0); PG8_BAR; PG8_MMA(0, 0, At, B0); PG8_MMA(0, 1, At, B1); PG8_BAR; PG8_SCHED;
            PG8_LDA(At, 1, 1); PG8_STAGE(PG8_SB(1, 0), b3, voffB); PG8_STAGE(PG8_SB(1, 1), b3 + hstepB, voffB); PG8_STAGE(PG8_SA(1, 0), a3, voffA);
            PG8_WAIT_V(8); PG8_WAIT_L(0); PG8_BAR; PG8_MMA(1, 0, At, B0); PG8_MMA(1, 1, At, B1); PG8_BAR; PG8_SCHED;
        }
        if constexpr (ALIGN_EPI) { if (wr == 0) PG8_BAR; }
        E(acc, cur, wr, wc, fr, fq);
        if (!has_next) break;
#pragma unroll
        for (int a = 0; a < 2; ++a)
#pragma unroll
            for (int b = 0; b < 2; ++b)
#pragma unroll
                for (int m = 0; m < 4; ++m)
#pragma unroll
                    for (int n = 0; n < 2; ++n) acc[a][b][m][n] = (f32x4){0.f, 0.f, 0.f, 0.f};
        cur = nxt; cA = nA; cB = nB; ++ui;
        if constexpr (ALIGN_EPI) { if (wr == 1) PG8_BAR; }
    }
    PG8_WAIT_V(0);
    if constexpr (!ALIGN_EPI) { if (wr == 0) PG8_BAR; }
    PG8_BAR;
#undef PG8_SA
#undef PG8_SB
#undef PG8_STAGE
#undef PG8_LDA
#undef PG8_LDB
#undef PG8_MMA
#undef PG8_WAIT_V
#undef PG8_WAIT_L
#undef PG8_BAR
#undef PG8_SCHED
}
}
namespace attn128 {
using bf16 = __hip_bfloat16;
typedef short bf16x8 __attribute__((ext_vector_type(8)));
typedef short s16x4 __attribute__((ext_vector_type(4)));
typedef float f32x16 __attribute__((ext_vector_type(16)));
typedef float f32x4 __attribute__((ext_vector_type(4)));
typedef unsigned u32x4 __attribute__((ext_vector_type(4)));
constexpr int D = 128, DK = 64, NW = 8, QBLK = 32, KVBLK = 64, QB = NW * QBLK;
constexpr int QS = ::LDP, KS = ::LDP, VS = ::LDP, OS = ::LDOC;
constexpr int SHM_V = KVBLK * D * 2, SHM_K = KVBLK * D * 2;
constexpr int LDS_BYTES = 2 * SHM_V + 2 * SHM_K + NW * 64 * 4;
constexpr float THR = 11.5f;
#ifndef ATT_NOPRIO
#define ATT_PRIO(x) __builtin_amdgcn_s_setprio(x)
#else
#define ATT_PRIO(x)
#endif
#define KSWZ(row, colB) ((row) * 256 + ((colB) ^ (((row) & 15) << 4)))
#define SBAR() __builtin_amdgcn_sched_barrier(0)
__device__ __forceinline__ int v_st(int k, int c) { const int kk = (k & ~0xC) | ((k & 4) << 1) | ((k & 8) >> 1); return ((kk >> 3) * 4 + (c >> 5)) * 512 + ((kk & 7) * 32 + (c & 31)) * 2; }
__device__ __forceinline__ int v_rd_base(int lane) { return ((lane & 3) << 3) | (((lane >> 2) & 3) << 6) | (((lane >> 4) & 1) << 5) | (((lane >> 5) & 1) << 8); }
constexpr int v_rd_off(int d0, int ks, int half) { return d0 * 512 + ks * 4096 + half * 2048; }
__device__ __forceinline__ int crow(int r, int hi) { return (r & 3) + 8 * (r >> 2) + 4 * hi; }
__device__ __forceinline__ unsigned cvtpk(float lo, float hi) { unsigned r; asm volatile("v_cvt_pk_bf16_f32 %0, %1, %2" : "=v"(r) : "v"(lo), "v"(hi)); return r; }
__device__ __forceinline__ unsigned cvtpk_b(float lo, float hi) { typedef float f2_ __attribute__((ext_vector_type(2))); typedef __bf16 b2_ __attribute__((ext_vector_type(2))); f2_ v = {lo, hi}; return __builtin_bit_cast(unsigned, __builtin_convertvector(v, b2_)); }
__device__ __forceinline__ bf16x8 load8(const bf16* p) { return *reinterpret_cast<const bf16x8*>(p); }
__device__ __forceinline__ void mask_tile(f32x16& p0, f32x16& p1, int dq) {
    const float NEG = -__builtin_inff();
#pragma unroll
    for (int r = 0; r < 16; ++r) { const int c = (r & 3) + 8 * (r >> 2);
        if (dq - c < 0) p0[r] = NEG;
        if (dq - c - 32 < 0) p1[r] = NEG; }
}
__device__ __forceinline__ void partialSM(f32x16& p0, f32x16& p1, float& m_reg, float& mn, float& alpha) {
    float pmax = p0[0]; for (int r = 1; r < 16; ++r) pmax = fmaxf(pmax, p0[r]); for (int r = 0; r < 16; ++r) pmax = fmaxf(pmax, p1[r]);
    { auto rr = __builtin_amdgcn_permlane32_swap(__float_as_uint(pmax), __float_as_uint(pmax), false, false);
      pmax = fmaxf(__uint_as_float(rr[0]), __uint_as_float(rr[1])); }
    if (__builtin_expect(__all((pmax - m_reg) <= THR), 1)) { mn = m_reg; alpha = 1.f; }
    else { mn = fmaxf(m_reg, pmax); alpha = __builtin_amdgcn_exp2f(m_reg - mn); m_reg = mn; }
    for (int r = 0; r < 16; ++r) p0[r] = p0[r] - mn; for (int r = 0; r < 16; ++r) p1[r] = p1[r] - mn;
    for (int r = 0; r < 16; ++r) p0[r] = __builtin_amdgcn_exp2f(p0[r]);
}
__device__ __forceinline__ void finishSM(f32x16& p0, f32x16& p1, bf16x8& pa0, bf16x8& pa1, bf16x8& pa2, bf16x8& pa3) {
    for (int r = 0; r < 16; ++r) p1[r] = __builtin_amdgcn_exp2f(p1[r]);
#define PK4(P, B_, OUT) do { unsigned a0 = cvtpk_b(P[B_+0], P[B_+1]), a1 = cvtpk_b(P[B_+2], P[B_+3]);                          \
        unsigned b0 = cvtpk_b(P[B_+4], P[B_+5]), b1 = cvtpk_b(P[B_+6], P[B_+7]);                                             \
        auto r0 = __builtin_amdgcn_permlane32_swap(a0, b0, false, false); auto r1 = __builtin_amdgcn_permlane32_swap(a1, b1, false, false); \
        u32x4 w = {r0[0], r1[0], r0[1], r1[1]}; OUT = *reinterpret_cast<bf16x8*>(&w); } while (0)
    PK4(p0, 0, pa0); PK4(p0, 8, pa1); PK4(p1, 0, pa2); PK4(p1, 8, pa3);
#undef PK4
}
template <int KB, bool PRIO = true>
__device__ __forceinline__ void qkt(f32x16& p0, f32x16& p1, const char* K_lds, int r32, int hi, const bf16x8* qr) {
    p0 = f32x16{}; p1 = f32x16{}; if (PRIO) ATT_PRIO(1);
#pragma unroll
    for (int d0 = 0; d0 < 4; ++d0) { const char* a = K_lds + KB * SHM_K + KSWZ(r32, (d0 * 16 + hi * 8) * 2);
        bf16x8 b0 = *reinterpret_cast<const bf16x8*>(a);
        bf16x8 b1 = *reinterpret_cast<const bf16x8*>(a + 32 * 256);
        p0 = __builtin_amdgcn_mfma_f32_32x32x16_bf16(b0, qr[d0], p0, 0, 0, 0);
        p1 = __builtin_amdgcn_mfma_f32_32x32x16_bf16(b1, qr[d0], p1, 0, 0, 0); }
    if (PRIO) ATT_PRIO(0);
}
template <int VB>
__device__ __forceinline__ void pv_tile(f32x16* o, int vb0, bf16x8 pa0, bf16x8 pa1, bf16x8 pa2, bf16x8 pa3) {
#define TRRD(dst, off) asm volatile("ds_read_b64_tr_b16 %0, %1 offset:%2" : "=&v"(dst) : "v"(vb0), "i"(off) : "memory")
#define PV_D0(d0) do { s16x4 l0, l1, l2, l3, h0, h1, h2, h3; constexpr int b_ = VB * SHM_V + v_rd_off(d0, 0, 0); \
        TRRD(l0, b_); TRRD(h0, b_ + 2048); TRRD(l1, b_ + 4096); TRRD(h1, b_ + 6144); TRRD(l2, b_ + 8192); TRRD(h2, b_ + 10240); TRRD(l3, b_ + 12288); TRRD(h3, b_ + 14336); \
        asm volatile("s_waitcnt lgkmcnt(0)" ::: "memory"); SBAR();   \
        o[d0] = __builtin_amdgcn_mfma_f32_32x32x16_bf16(pa0, (bf16x8){l0[0], l0[1], l0[2], l0[3], h0[0], h0[1], h0[2], h0[3]}, o[d0], 0, 0, 0);   \
        o[d0] = __builtin_amdgcn_mfma_f32_32x32x16_bf16(pa1, (bf16x8){l1[0], l1[1], l1[2], l1[3], h1[0], h1[1], h1[2], h1[3]}, o[d0], 0, 0, 0);   \
        o[d0] = __builtin_amdgcn_mfma_f32_32x32x16_bf16(pa2, (bf16x8){l2[0], l2[1], l2[2], l2[3], h2[0], h2[1], h2[2], h2[3]}, o[d0], 0, 0, 0);   \
        o[d0] = __builtin_amdgcn_mfma_f32_32x32x16_bf16(pa3, (bf16x8){l3[0], l3[1], l3[2], l3[3], h3[0], h3[1], h3[2], h3[3]}, o[d0], 0, 0, 0); } while (0)
    ATT_PRIO(1); PV_D0(0); PV_D0(1); PV_D0(2); PV_D0(3);
#undef PV_D0
#undef TRRD
    const bf16x8 ones = {16256, 16256, 16256, 16256, 16256, 16256, 16256, 16256};
    o[4] = __builtin_amdgcn_mfma_f32_32x32x16_bf16(pa0, ones, o[4], 0, 0, 0); o[4] = __builtin_amdgcn_mfma_f32_32x32x16_bf16(pa1, ones, o[4], 0, 0, 0);
    o[4] = __builtin_amdgcn_mfma_f32_32x32x16_bf16(pa2, ones, o[4], 0, 0, 0); o[4] = __builtin_amdgcn_mfma_f32_32x32x16_bf16(pa3, ones, o[4], 0, 0, 0); ATT_PRIO(0);
}
__device__ __forceinline__ void partialSM_bf(f32x16& p0, f32x16& p1, float& m_reg, float& alpha) {
    float pmax = p0[0]; for (int r = 1; r < 16; ++r) pmax = fmaxf(pmax, p0[r]); for (int r = 0; r < 16; ++r) pmax = fmaxf(pmax, p1[r]);
    { auto rr = __builtin_amdgcn_permlane32_swap(__float_as_uint(pmax), __float_as_uint(pmax), false, false);
      pmax = fmaxf(__uint_as_float(rr[0]), __uint_as_float(rr[1])); }
    const float mn = (pmax - m_reg > THR) ? pmax : m_reg;
    alpha = __builtin_amdgcn_exp2f(m_reg - mn); m_reg = mn;
    for (int r = 0; r < 16; ++r) p0[r] = p0[r] - mn; for (int r = 0; r < 16; ++r) p1[r] = p1[r] - mn;
    for (int r = 0; r < 16; ++r) p0[r] = __builtin_amdgcn_exp2f(p0[r]);
}
typedef __attribute__((address_space(3))) char lchar;
__device__ __forceinline__ s16x4 vtrb(const lchar* p) { typedef short v4i16_t __attribute__((ext_vector_type(4))); typedef __attribute__((address_space(3))) v4i16_t* lp_t; return __builtin_bit_cast(s16x4, __builtin_amdgcn_ds_read_tr16_b64_v4i16((lp_t)p)); }
template <int VB>
__device__ __forceinline__ void pv_tile_b(f32x16* o, const lchar* vl, bf16x8 pa0, bf16x8 pa1, bf16x8 pa2, bf16x8 pa3) {
#pragma unroll
    for (int d0 = 0; d0 < 4; ++d0) { const lchar* b = vl + VB * SHM_V + v_rd_off(d0, 0, 0);
        const s16x4 l0 = vtrb(b), h0 = vtrb(b + 2048), l1 = vtrb(b + 4096), h1 = vtrb(b + 6144), l2 = vtrb(b + 8192), h2 = vtrb(b + 10240), l3 = vtrb(b + 12288), h3 = vtrb(b + 14336);
        o[d0] = __builtin_amdgcn_mfma_f32_32x32x16_bf16(pa0, (bf16x8){l0[0], l0[1], l0[2], l0[3], h0[0], h0[1], h0[2], h0[3]}, o[d0], 0, 0, 0);
        o[d0] = __builtin_amdgcn_mfma_f32_32x32x16_bf16(pa1, (bf16x8){l1[0], l1[1], l1[2], l1[3], h1[0], h1[1], h1[2], h1[3]}, o[d0], 0, 0, 0);
        o[d0] = __builtin_amdgcn_mfma_f32_32x32x16_bf16(pa2, (bf16x8){l2[0], l2[1], l2[2], l2[3], h2[0], h2[1], h2[2], h2[3]}, o[d0], 0, 0, 0);
        o[d0] = __builtin_amdgcn_mfma_f32_32x32x16_bf16(pa3, (bf16x8){l3[0], l3[1], l3[2], l3[3], h3[0], h3[1], h3[2], h3[3]}, o[d0], 0, 0, 0); }
    const bf16x8 ones = {16256, 16256, 16256, 16256, 16256, 16256, 16256, 16256};
    o[4] = __builtin_amdgcn_mfma_f32_32x32x16_bf16(pa0, ones, o[4], 0, 0, 0); o[4] = __builtin_amdgcn_mfma_f32_32x32x16_bf16(pa1, ones, o[4], 0, 0, 0);
    o[4] = __builtin_amdgcn_mfma_f32_32x32x16_bf16(pa2, ones, o[4], 0, 0, 0); o[4] = __builtin_amdgcn_mfma_f32_32x32x16_bf16(pa3, ones, o[4], 0, 0, 0);
}
struct BlockRef { const bf16* Q; const bf16* K; const bf16* V; bf16* O; int P0; };
struct Seam { bf16x8 qr[4]; bf16x8 st_v0, st_v1, st_k0; };
#define VMW() asm volatile("s_waitcnt vmcnt(0)" ::: "memory")
#define VMWN(n) asm volatile("s_waitcnt vmcnt(%0)" :: "i"(n) : "memory")
#define SLOAD_H(Kp, Vp, k0) do { S.st_v0 = load8((Vp) + (size_t)((k0) + sr) * VS + sc); S.st_v1 = load8((Vp) + (size_t)((k0) + 32 + sr) * VS + sc); \
                                 S.st_k0 = load8((Kp) + (size_t)((k0) + kr) * KS + kc); } while (0)
#define SWRITE_HK(bf) do { *(bf16x8*)(K_lds + (bf) * SHM_K + kws) = S.st_k0; } while (0)
#define SWRITE_HV(bf) do { *(bf16x8*)(V_lds + (bf) * SHM_V + vst0) = S.st_v0; *(bf16x8*)(V_lds + (bf) * SHM_V + vst1) = S.st_v1; } while (0)
#define SWRITE_H(bf) do { SWRITE_HV(bf); SWRITE_HK(bf); } while (0)
__device__ __forceinline__ void causal_prime(const BlockRef& cur, char* lds, Seam& S) {
    int tid = threadIdx.x; asm volatile("" : "+v"(tid));
    const int wid = __builtin_amdgcn_readfirstlane(tid >> 6), lane = tid & 63, r32 = lane & 31, hi = lane >> 5;
    const int sr = tid >> 4, sc = (tid & 15) * 8, kr = tid >> 3, kc = (tid & 7) * 8, kws = KSWZ(kr, kc * 2); char* K_lds = lds + 2 * SHM_V;
    for (int d0 = 0; d0 < 4; ++d0) S.qr[d0] = load8(cur.Q + (size_t)(wid * QBLK + r32) * QS + d0 * 16 + hi * 8);
    SLOAD_H(cur.K, cur.V, 0); VMW(); SWRITE_HK(0);
    __syncthreads();
}
__device__ __forceinline__ void causal_block(const BlockRef& cur, const BlockRef& nxt, char* lds, Seam& S) {
    int tid = threadIdx.x; asm volatile("" : "+v"(tid));
    const int wid = __builtin_amdgcn_readfirstlane(tid >> 6), lane = tid & 63, r32 = lane & 31, hi = lane >> 5;
    const int NT = (cur.P0 + QB) / KVBLK;
    const int qlo = cur.P0 + wid * QBLK, qm = qlo + r32 - 4 * hi;
    char* V_lds = lds; char* K_lds = lds + 2 * SHM_V;
    float* ws = (float*)(lds + 2 * SHM_V + 2 * SHM_K) + wid * 64; float* li_l = ws, * al_l = ws + 32;
    float m_reg = -1e30f; f32x16 o[5] = {};
    const int sr = tid >> 4, sc = (tid & 15) * 8, vst0 = v_st(sr, sc), vst1 = v_st(32 + sr, sc), kr = tid >> 3, kc = (tid & 7) * 8, kws = KSWZ(kr, kc * 2);
    const int vb0 = (int)(uintptr_t)V_lds + v_rd_base(lane);
    const lchar* vl = (const lchar*)(size_t)(unsigned)vb0;
    const bf16* Kh = cur.K; const bf16* Vh = cur.V;
#define RESC(a) do { if (__any((a) < 1.f)) { if (hi == 0) al_l[r32] = (a); asm volatile("s_waitcnt lgkmcnt(0)" ::: "memory");              \
                     for (int d_ = 0; d_ < 5; ++d_) for (int r = 0; r < 16; ++r) o[d_][r] *= al_l[crow(r, hi)]; } } while (0)
#define KBASE(t) ((t) * KVBLK)
#define MASKT(P0_, P1_, t) do { const int kb_ = KBASE(t); if (kb_ + KVBLK - 1 > qlo) mask_tile(P0_, P1_, qm - kb_); } while (0)
#define SEAM_K0() do { VMWN(4); SWRITE_HK(0); SBAR(); } while (0)
    f32x16 pA0, pA1, pB0, pB1; float mnA, mnB, alA, alB; bf16x8 pa0, pa1, pa2, pa3;
    SWRITE_HV(0); SBAR();
    SLOAD_H(Kh, Vh, KBASE(1));
    SBAR(); qkt<0>(pA0, pA1, K_lds, r32, hi, S.qr);
    MASKT(pA0, pA1, 0); partialSM(pA0, pA1, m_reg, mnA, alA);
    VMW(); SWRITE_H(1);
    __syncthreads();
#define SGB(mask, n) __builtin_amdgcn_sched_group_barrier(mask, n, 0)
#define R1_PIPE() do { SGB(0x100, 4); _Pragma("unroll") for (int i_ = 0; i_ < 4; ++i_) { SGB(0x008, 1); SGB(0x402, 5); SGB(0x100, 1); } _Pragma("unroll") for (int i_ = 0; i_ < 4; ++i_) { SGB(0x008, 1); SGB(0x402, 5); } } while (0)
#define R2_PIPE() do { SGB(0x100, 8); _Pragma("unroll") for (int i_ = 0; i_ < 12; ++i_) { SGB(0x008, 1); SGB(0x402, 4); SGB(0x100, 2); } _Pragma("unroll") for (int i_ = 0; i_ < 8; ++i_) { SGB(0x008, 1); SGB(0x402, 4); } } while (0)
#define PIN2(P0_, P1_) asm volatile("" : "+v"(P0_), "+v"(P1_))
#define HALF_STEP(PX0, PX1, mnX, alX, PY0, PY1, alY, t, KB, VB, SB) do {                                                      \
        SBAR(); qkt<KB, false>(PX0, PX1, K_lds, r32, hi, S.qr);                                                               \
        finishSM(PY0, PY1, pa0, pa1, pa2, pa3); R1_PIPE(); SBAR();                                                            \
        if ((t) + 1 < NT) { SLOAD_H(Kh, Vh, KBASE((t) + 1)); SBAR(); }                                                        \
        MASKT(PX0, PX1, (t)); SBAR();                                                                                         \
        pv_tile_b<VB>(o, vl, pa0, pa1, pa2, pa3); partialSM_bf(PX0, PX1, m_reg, alX); R2_PIPE(); PIN2(PX0, PX1); SBAR();      \
        __syncthreads();                                                                                                      \
        if ((t) + 1 < NT) { VMW(); SWRITE_H(SB); }                                                                            \
        RESC(alX); __syncthreads(); } while (0)
    for (int t = 1; t + 1 < NT; t += 2) {
        HALF_STEP(pB0, pB1, mnB, alB, pA0, pA1, alA, t, 1, 0, 0);
        HALF_STEP(pA0, pA1, mnA, alA, pB0, pB1, alB, t + 1, 0, 1, 1);
    }
    SBAR(); qkt<1>(pB0, pB1, K_lds, r32, hi, S.qr); SBAR();
    SLOAD_H(nxt.K, nxt.V, 0); SBAR();
#pragma unroll
    for (int d0 = 0; d0 < 4; ++d0) S.qr[d0] = load8(nxt.Q + (size_t)(wid * QBLK + r32) * QS + d0 * 16 + hi * 8);
    SBAR();
    finishSM(pA0, pA1, pa0, pa1, pa2, pa3); SBAR();
    pv_tile<0>(o, vb0, pa0, pa1, pa2, pa3);
    MASKT(pB0, pB1, NT - 1); partialSM(pB0, pB1, m_reg, mnB, alB); __syncthreads(); RESC(alB);
    finishSM(pB0, pB1, pa0, pa1, pa2, pa3); SBAR(); pv_tile<1>(o, vb0, pa0, pa1, pa2, pa3);
    SBAR(); SEAM_K0();
    float rli[16];
#pragma unroll
    for (int r = 0; r < 16; ++r) rli[r] = __builtin_amdgcn_rcpf(o[4][r]);
    bf16* Ow = cur.O + (size_t)(wid * QBLK) * OS;
#pragma unroll
    for (int r = 0; r < 16; ++r) { const int orow = crow(r, hi);
#pragma unroll
        for (int d0 = 0; d0 < 4; ++d0) { const float v = o[d0][r] * rli[r]; const float vn = __shfl_xor(v, 1);
            if ((r32 & 1) == 0) *(unsigned*)(Ow + (size_t)orow * OS + d0 * 32 + r32) = cvtpk(v, vn); } }
    __syncthreads();
#undef RESC
#undef KBASE
#undef MASKT
#undef SEAM_K0
#undef HALF_STEP
#undef R2_PIPE
#undef PIN2
#undef R1_PIPE
#undef SGB
}
#undef VMW
#undef VMWN
#undef SLOAD_H
#undef SWRITE_HK
#undef SWRITE_HV
#undef SWRITE_H
__device__ __forceinline__ BlockRef make_ref(const bf16* P, bf16* OC, int p, int pass) {
    const int s = p & 7, bhc = p >> 3, b = bhc >> 4, hc = bhc & 15, qb = pass ? 15 - s : s; BlockRef r;
    const size_t row0 = (size_t)b * ::SEQ;
    r.Q = P + (row0 + (size_t)qb * QB) * QS + ::C_QA + hc * 64; r.K = P + row0 * KS + ::C_KA + hc * 64; r.V = P + row0 * VS + ::C_VA + (hc >> 1) * 128;
    r.O = OC + (row0 + (size_t)qb * QB) * OS + hc * 128; r.P0 = qb * QB; return r;
}
__device__ __forceinline__ void attn_phase(char* lds, const bf16* P, bf16* OC, int vcu, int G) {
    int p = vcu; if (p >= 256) return; int pass = 0;
    BlockRef cur = make_ref(P, OC, p, 0); Seam S;
    causal_prime(cur, lds, S);
    for (;;) {
        const bool more_pass = pass == 0, more_item = p + G < 256, last = !more_pass && !more_item;
        int pn = p, passn = pass + 1; if (!more_pass) { passn = 0; pn = more_item ? p + G : p; }
        const BlockRef nxt = last ? cur : make_ref(P, OC, pn, passn);
        causal_block(cur, nxt, lds, S);
        if (last) break;
        cur = nxt; p = pn; pass = passn;
    }
}
#undef KSWZ
#undef SBAR
}
constexpr int NWAVES = 8;
#ifndef MK_SPLIT
#define MK_SPLIT 0
#endif
constexpr int N_PHASES = 3 + 6 * DEPTH;

constexpr size_t MiB = 1u << 20;
constexpr size_t WS_CTL = 0, CTL_ZERO_BYTES = 1 * MiB;
constexpr size_t WS_SS = 512 * 1024;
constexpr size_t WS_COSA = 1 * MiB, WS_SINA = WS_COSA + 512 * 1024;
constexpr size_t WS_COSB = 2 * MiB, WS_SINB = 3 * MiB;
constexpr size_t WS_LSE = 4 * MiB;
constexpr size_t WS_PWT = 6 * MiB;
constexpr size_t WS_WUNT = 8 * MiB;
constexpr size_t WS_W = 32 * MiB;
constexpr size_t W_IN = 0, W_OUT = 80 * MiB, W_UP = 112 * MiB, W_DN = 240 * MiB, W_LAYER = 368 * MiB;
constexpr size_t WS_HN = WS_W + DEPTH * W_LAYER;
constexpr size_t WS_PROJ = WS_HN + 66 * MiB;
constexpr size_t WS_MIX = WS_PROJ + 162 * MiB;
constexpr size_t WS_OC = WS_MIX + 66 * MiB;
constexpr size_t WS_ACT = WS_OC + 34 * MiB;
constexpr size_t WS_END = WS_ACT + 258 * MiB;
static_assert(WS_HN == 768 * MiB && (size_t)M * LDH * 2 <= 66 * MiB && (size_t)M * LDP * 2 <= 162 * MiB && (size_t)M * LDOC * 2 <= 34 * MiB && (size_t)M * LDACT * 2 <= 258 * MiB && WS_END <= 1400 * MiB, "d_ws map");
constexpr int CW_RANK = 8192;
constexpr int CW_BAR = 4096;

constexpr int RING_OFF = 0, RING_BYTES = 131072;
constexpr int LDSCTL_OFF = RING_BYTES, MISC_OFF = LDSCTL_OFF + 320;
constexpr int LDS_BYTES = 147456;
static_assert(MISC_OFF + 128 <= LDS_BYTES && attn128::LDS_BYTES <= RING_BYTES, "LDS map");

#define LAS __attribute__((address_space(3)))
typedef unsigned short bf16;
typedef unsigned v4u __attribute__((ext_vector_type(4)));
typedef unsigned v2u __attribute__((ext_vector_type(2)));
typedef float f32x4 __attribute__((ext_vector_type(4)));
typedef float f32x16 __attribute__((ext_vector_type(16)));
typedef short bf16x8 __attribute__((ext_vector_type(8)));
typedef short s16x4 __attribute__((ext_vector_type(4)));
using pg8::cvt_pk_bf16;
__device__ __forceinline__ float bf_lo(unsigned u) { return __uint_as_float(u << 16); }
__device__ __forceinline__ float bf_hi(unsigned u) { return __uint_as_float(u & 0xffff0000u); }

#define XB_TMO      128
#define XB_XCNT(j)  (256  + 64 * (j))
#define XB_XSUB(j)  (1280 + 64 * (j))
#define XB_XGEN(j)  (2304 + 64 * (j))
#define XB_TOP      3328
#define XB_TOPGEN   3392
#define XCD_BAR_WORDS 3456
#define XB_SPIN_CAP (1u << 18)

__device__ __forceinline__ unsigned xb_ld(unsigned* p)              { return __hip_atomic_load(p, __ATOMIC_RELAXED, __HIP_MEMORY_SCOPE_AGENT); }
__device__ __forceinline__ unsigned xb_add(unsigned* p, unsigned v) { return __hip_atomic_fetch_add(p, v, __ATOMIC_RELAXED, __HIP_MEMORY_SCOPE_AGENT); }
__device__ __forceinline__ unsigned xb_xcc_id() { return (unsigned)__builtin_amdgcn_s_getreg((3 << 11) | 20) & 0xFu; }
#define XB_SPIN(cond, bar) do { unsigned _sp = 0; while (cond) { __builtin_amdgcn_s_sleep(1); \
    if ((++_sp & 255u) == 0u) { if (xb_ld(&(bar)[XB_TMO])) break; if (_sp > XB_SPIN_CAP) { atomicAdd(&(bar)[XB_TMO], 1u); break; } } } } while (0)

struct XcdBarrier {
    unsigned* bar; unsigned x;
    volatile LAS unsigned* st;
};
__device__ __forceinline__ XcdBarrier xcd_barrier_post(unsigned* bar, volatile LAS unsigned* st) {
    XcdBarrier b; b.bar = bar; b.x = xb_xcc_id(); b.st = st;
    if (threadIdx.x == 0) (void)xb_add(&bar[XB_XCNT(b.x)], 1u);
    return b;
}
__device__ __forceinline__ void xcd_barrier_complete(unsigned* bar, unsigned x, unsigned& nloc, unsigned& nx) {
    const unsigned G = gridDim.x * gridDim.y * gridDim.z;
    unsigned sum, cnt, mine, sp = 0u;
    for (;;) {
        sum = 0u; cnt = 0u; mine = 0u;
#pragma unroll
        for (unsigned j = 0; j < 16; ++j) { const unsigned c = xb_ld(&bar[XB_XCNT(j)]); sum += c; cnt += (c > 0u) ? 1u : 0u; mine = (j == x) ? c : mine; }
        if (sum == G) break;
        __builtin_amdgcn_s_sleep(1);
        if ((++sp & 255u) == 0u) { if (xb_ld(&bar[XB_TMO])) break; if (sp > XB_SPIN_CAP) { atomicAdd(&bar[XB_TMO], 1u); break; } }
    }
    nloc = mine > 0u ? mine : 1u; nx = cnt > 0u ? cnt : 1u;
}
__device__ __forceinline__ void xcd_barrier(const XcdBarrier& b) {
    asm volatile("s_waitcnt vmcnt(0)" ::: "memory");
    __syncthreads();
    if (threadIdx.x == 0) {
        unsigned* bar = b.bar;
        __builtin_amdgcn_s_waitcnt(0);
        unsigned nloc = b.st[0], nx = b.st[1];
        if (nloc == 0u) { xcd_barrier_complete(bar, b.x, nloc, nx); b.st[0] = nloc; b.st[1] = nx; }
        const unsigned old = xb_add(&bar[XB_XSUB(b.x)], 1u);
        const unsigned gen = old / nloc;
        if (old + 1u == (gen + 1u) * nloc) {
            __builtin_amdgcn_fence(__ATOMIC_RELEASE, "agent");
            asm volatile("s_waitcnt vmcnt(0)" ::: "memory");
            const unsigned og = xb_add(&bar[XB_TOP], 1u);
            const unsigned tg = og / nx;
            if (og + 1u == (tg + 1u) * nx) xb_add(&bar[XB_TOPGEN], 1u);
            else XB_SPIN(xb_ld(&bar[XB_TOPGEN]) == tg, bar);
            __builtin_amdgcn_fence(__ATOMIC_ACQUIRE, "agent");
            xb_add(&bar[XB_XGEN(b.x)], 1u);
            asm volatile("s_waitcnt vmcnt(0)" ::: "memory");
        } else {
            XB_SPIN(xb_ld(&bar[XB_XGEN(b.x)]) == gen, bar);
            __builtin_amdgcn_fence(__ATOMIC_ACQUIRE, "agent");
            asm volatile("s_waitcnt vmcnt(0)" ::: "memory");
        }
    }
    __syncthreads();
}

struct Args { const float* in[13]; float* out; unsigned char* ws; int ph_lo, ph_hi; };
__device__ __forceinline__ float wave_sum(float v) {
#pragma unroll
    for (int o = 1; o < 64; o <<= 1) v += __shfl_xor(v, o);
    return v;
}
__device__ __forceinline__ int nperm(int n) {
    const int tile = n >> 8, c = n & 255; int cp = c;
    if (tile < 8) { const int q = c >> 6, i = c & 63; cp = (i < 32) ? 32 * q + i : 128 + 32 * q + (i - 32); }
    else if (tile >= 12 && tile <= 20) { const int u = c >> 7, i = c & 127; cp = (i < 64) ? 64 * u + i : 128 + 64 * u + (i - 64); }
    return tile * 256 + cp;
}
template <int MODE, int K, int N>
__device__ __forceinline__ void conv_blocked(const float* __restrict__ W, bf16* D, const float* __restrict__ gk, unsigned gtid, unsigned nthr, LAS unsigned char* scr  ) {
    constexpr unsigned items = (unsigned)(K >> 5) * (unsigned)N;
    const int lane = (int)(gtid & 63u);
    for (unsigned it = gtid; it < items; it += nthr) {
        const unsigned kb = it / (unsigned)N; const int n = (int)(it - kb * (unsigned)N), k0 = (int)kb * 32;
        if (MODE == 1 && n >= C_U && n < C_GB) continue;
        const float* src = W + (size_t)k0 * N + n;
        float v[32];
#pragma unroll
        for (int i = 0; i < 32; ++i) v[i] = __builtin_nontemporal_load(src + (size_t)i * N);
        if (gk) {
#pragma unroll
            for (int i = 0; i < 32; ++i) v[i] *= gk[k0 + i];
        }
        const int rho = pg8::p32inv(lane & 31), half = lane >> 5;
#pragma unroll
        for (int c = 0; c < 4; ++c) { v4u o; o.x = cvt_pk_bf16(v[8 * c], v[8 * c + 1]); o.y = cvt_pk_bf16(v[8 * c + 2], v[8 * c + 3]); o.z = cvt_pk_bf16(v[8 * c + 4], v[8 * c + 5]); o.w = cvt_pk_bf16(v[8 * c + 6], v[8 * c + 7]);
            *(LAS v4u*)(scr + (half * 32 + rho) * 64 + ((c * 16) ^ ((rho & 8) << 2))) = o; }
        const int nb = n - lane;
#pragma unroll
        for (int i = 0; i < 4; ++i) { const int h2 = i >> 1, b2 = i & 1; const int gp = ((MODE == 1) ? nperm(nb + 32 * h2) : nb + 32 * h2) & ~31;
            const v4u o = *(const LAS v4u*)(scr + (h2 * 32 + b2 * 16) * 64 + lane * 16);
            *(v4u*)((unsigned char*)D + ((size_t)((gp >> 4) + b2) * (K >> 5) + (size_t)(k0 >> 5)) * 1024 + lane * 16) = o; }
        asm volatile("s_waitcnt lgkmcnt(0)" ::: "memory");
    }
}
__device__ __forceinline__ void xb_rows(const float* X, bf16* H, pg8::ss_t* ss, int gw, int ngw, int lane) {
    asm volatile("" : "+v"(lane));
    for (int m = gw; m < M; m += ngw) {
        const f32x4* xr = (const f32x4*)(X + (size_t)m * DM) + lane;
        f32x4 v[16]; float s = 0.f;
#pragma unroll
        for (int j = 0; j < 16; ++j) { v[j] = xr[64 * j]; s += (v[j].x * v[j].x + v[j].y * v[j].y) + (v[j].z * v[j].z + v[j].w * v[j].w); }
        s = wave_sum(s); if (lane == 0) ss[m] = (pg8::ss_t)(s * pg8::SS_SCALE);
#pragma unroll
        for (int j = 0; j < 16; ++j) { v2u o; o.x = cvt_pk_bf16(v[j].x, v[j].y); o.y = cvt_pk_bf16(v[j].z, v[j].w); *(v2u*)(H + pg8::img_elem(m, 4 * (lane + 64 * j), DM)) = o; }
    }
}
__device__ __forceinline__ void rmsnorm_final(const bf16* XB, const pg8::ss_t* __restrict__ ss, float* out, const float* __restrict__ g, int gw, int ngw, int lane) {
    asm volatile("" : "+v"(lane));
    for (int m = gw; m < M; m += ngw) {
        const float rstd = 1.f / sqrtf((float)ss[m] * (pg8::SS_INV / DM) + 1e-6f); f32x4* orow = (f32x4*)(out + (size_t)m * DM) + lane; const f32x4* gr = (const f32x4*)g + lane;
#pragma unroll
        for (int j = 0; j < 16; ++j) { const v2u w = *(const v2u*)(XB + pg8::img_elem(m, 4 * (lane + 64 * j), DM));
            const f32x4 x = {bf_lo(w.x), bf_hi(w.x), bf_lo(w.y), bf_hi(w.y)}; orow[64 * j] = x * rstd * gr[64 * j]; }
    }
}

__device__ __forceinline__ void p0_prologue(const __attribute__((address_space(4))) Args* ka, unsigned char* ws, unsigned gtid, unsigned nthr, int gw, int ngw, int lane, LAS unsigned char* scr) {
    const float* in[13];
#pragma unroll
    for (int i = 0; i < 13; ++i) in[i] = ka->in[i];
    { float* cosA = (float*)(ws + WS_COSA); float* sinA = (float*)(ws + WS_SINA); float* cosB = (float*)(ws + WS_COSB); float* sinB = (float*)(ws + WS_SINB);
      for (unsigned it = gtid; it < (unsigned)SEQ * 96u; it += nthr) { const unsigned pos = it / 96u, j = it - pos * 96u; const bool isA = j < 32u; const int i = isA ? (int)j : (int)j - 32;
          const double inv = exp2(-(double)i * (isA ? (1.0 / 32.0) : (1.0 / 64.0)) * 13.287712379549449);
          double rev = (double)pos * inv * 0.15915494309189535; rev -= rint(rev);
          const float rv = (float)rev, c = __builtin_amdgcn_cosf(rv), s = __builtin_amdgcn_sinf(rv);
          if (isA) { cosA[pos * 32 + i] = c; sinA[pos * 32 + i] = s; } else { cosB[pos * 64 + i] = c; sinB[pos * 64 + i] = s; } } }
    { const float* pw = in[7]; const float* ps = in[8]; bf16* PWT = (bf16*)(ws + WS_PWT);
      for (unsigned it = gtid; it < (unsigned)DEPTH * 4u * 256u * 32u; it += nthr) { const unsigned c8 = it & 31u, d = (it >> 5) & 255u, lg = it >> 13;
          const float sc = ps[lg * 256u + d]; const float* src = pw + ((size_t)lg * 256 + c8 * 8) * 256 + d; float v[8];
#pragma unroll
          for (int i = 0; i < 8; ++i) v[i] = src[(size_t)i * 256] * sc;
          v4u o; o.x = cvt_pk_bf16(v[0], v[1]); o.y = cvt_pk_bf16(v[2], v[3]); o.z = cvt_pk_bf16(v[4], v[5]); o.w = cvt_pk_bf16(v[6], v[7]);
          *(v4u*)(PWT + pg8::img_elem((int)(lg * 256u + d), (int)c8 * 8, 256)) = o; } }
    { for (unsigned it = gtid; it < (unsigned)DEPTH * 4096u * 128u; it += nthr) { const unsigned cc = it & 127u, k = (it >> 7) & 4095u, l = it >> 19, g = cc >> 5, c8 = cc & 31u;
          const float* src = in[1] + ((size_t)l * DM + k) * NIN + C_U + cc * 8; const float gm = in[3][l * DM + k];
          const f32x4 a = *(const f32x4*)src * gm, b = *(const f32x4*)(src + 4) * gm;
          v4u o; o.x = cvt_pk_bf16(a[0], a[1]); o.y = cvt_pk_bf16(a[2], a[3]); o.z = cvt_pk_bf16(b[0], b[1]); o.w = cvt_pk_bf16(b[2], b[3]);
          *(v4u*)((bf16*)(ws + WS_WUNT) + (size_t)(l * 4 + g) * (4096 * 256) + pg8::img_elem(pg8::brow((int)k), (int)c8 * 8, 256)) = o; } }
#ifndef PROBE_P0
#define PROBE_P0 1
#endif
    for (int l2 = 0; l2 < DEPTH * PROBE_P0; ++l2) { const int l = DEPTH - 1 - (l2 % DEPTH);
        unsigned char* wl = ws + WS_W + (size_t)l * W_LAYER;
        conv_blocked<0, DFF, DM>(in[11] + (size_t)l * DFF * DM, (bf16*)(wl + W_DN), nullptr, gtid, nthr, scr);
        conv_blocked<0, DM, DFF>(in[10] + (size_t)l * DM * DFF, (bf16*)(wl + W_UP), in[4] + l * DM, gtid, nthr, scr);
        conv_blocked<0, DM, DM>(in[2] + (size_t)l * DM * DM, (bf16*)(wl + W_OUT), nullptr, gtid, nthr, scr);
        conv_blocked<1, DM, NIN>(in[1] + (size_t)l * DM * NIN, (bf16*)(wl + W_IN), in[3] + l * DM, gtid, nthr, scr);
    }
    xb_rows(in[0], (bf16*)(ws + WS_HN), (pg8::ss_t*)(ws + WS_SS), gw, ngw, lane);
}

__device__ __forceinline__ s16x4 vtr(const LAS char* p) { typedef short v4i16_t __attribute__((ext_vector_type(4))); return __builtin_bit_cast(s16x4, __builtin_amdgcn_ds_read_tr16_b64_v4i16((LAS v4i16_t*)p)); }
__device__ __forceinline__ int crow(int r, int hi) { return (r & 3) + 8 * (r >> 2) + 4 * hi; }
__device__ __forceinline__ void dil_tile(const bf16* __restrict__ P, bf16* MIX, float* LSE, int T, LAS char* vimg, int lane) {
    asm volatile("" : "+v"(lane));
    const int r32 = lane & 31, hi = lane >> 5;
    const int bh = T >> 7, within = T & 127, b = bh / 9, head = bh - 9 * b, gi = head / 3, dsh = 2 * gi;
    const int L32 = 128 >> dsh, r = within >> (7 - dsh), i0 = (within & (L32 - 1)) << 5, j0 = i0 - 128;
    const size_t row0 = (size_t)b * SEQ + r;
    bf16x8 qf[8];
    { const bf16* qp = P + (row0 + ((size_t)(i0 + r32) << dsh)) * LDP + C_QB + head * 128 + 8 * hi;
#pragma unroll
      for (int s = 0; s < 8; ++s) qf[s] = *(const bf16x8*)(qp + 16 * s); }
    f32x16 S[5];
#pragma unroll
    for (int kt = 0; kt < 5; ++kt) {
        int ln = lane; asm volatile("" : "+v"(ln));
#pragma unroll
        for (int it = 0; it < 8; ++it) { const int rr = (ln >> 4) + 4 * it, c16 = ln & 15; const int key = j0 + 32 * kt + rr, kc = key < 0 ? 0 : key;
            __builtin_amdgcn_global_load_lds((const unsigned*)(P + (row0 + ((size_t)kc << dsh)) * LDP + C_KB + head * 128 + 8 * (c16 ^ (rr & 15))), (LAS unsigned*)(vimg + it * 1024), 16, 0, 0); }
        asm volatile("s_waitcnt vmcnt(0)" ::: "memory");
        bf16x8 kf[8];
#pragma unroll
        for (int s = 0; s < 8; ++s) kf[s] = *(const LAS bf16x8*)(vimg + r32 * 256 + (((2 * s + hi) ^ (r32 & 15)) << 4));
        asm volatile("s_waitcnt lgkmcnt(0)" ::: "memory");
        f32x16 a = {};
#pragma unroll
        for (int s = 0; s < 8; ++s) a = __builtin_amdgcn_mfma_f32_32x32x16_bf16(kf[s], qf[s], a, 0, 0, 0);
        S[kt] = a; }
    const int iq = i0 + r32; float mx = -INFINITY;
#pragma unroll
    for (int kt = 0; kt < 5; ++kt)
#pragma unroll
        for (int g = 0; g < 16; ++g) { const int key = j0 + 32 * kt + crow(g, hi); const bool ok = (key >= 0) && (key <= iq) && (key >= iq - 128); const float v = ok ? S[kt][g] : -INFINITY; S[kt][g] = v; mx = fmaxf(mx, v); }
    mx = fmaxf(mx, __shfl_xor(mx, 32));
    float l = 0.f;
#pragma unroll
    for (int kt = 0; kt < 5; ++kt)
#pragma unroll
        for (int g = 0; g < 16; ++g) { const float p = __builtin_amdgcn_exp2f(S[kt][g] - mx); S[kt][g] = p; l += p; }
    l += __shfl_xor(l, 32);
    if (hi == 0) LSE[(row0 + ((size_t)iq << dsh)) * 16 + head] = mx + __builtin_amdgcn_logf(l);
    const float rl = 1.f / l;
    f32x16 O[4] = {};
#pragma unroll
    for (int kt = 0; kt < 5; ++kt) {
#pragma unroll
        for (int it = 0; it < 8; ++it) { const int rr = (lane >> 4) + 4 * it, c16 = lane & 15; const int key = j0 + 32 * kt + rr, kc = key < 0 ? 0 : key;
            const v4u v = *(const v4u*)(P + (row0 + ((size_t)kc << dsh)) * LDP + C_VB + head * 128 + 8 * c16);
            *(LAS v4u*)(vimg + (c16 >> 2) * 2048 + rr * 64 + (c16 & 3) * 16) = v; }
        const LAS char* vb = vimg + ((lane >> 4) & 1) * 32 + (lane & 3) * 8 + (4 * hi + ((lane & 15) >> 2)) * 64;
#pragma unroll
        for (int s2 = 0; s2 < 2; ++s2) {
            v4u pw; pw.x = cvt_pk_bf16(S[kt][8 * s2 + 0] * rl, S[kt][8 * s2 + 1] * rl); pw.y = cvt_pk_bf16(S[kt][8 * s2 + 2] * rl, S[kt][8 * s2 + 3] * rl);
            pw.z = cvt_pk_bf16(S[kt][8 * s2 + 4] * rl, S[kt][8 * s2 + 5] * rl); pw.w = cvt_pk_bf16(S[kt][8 * s2 + 6] * rl, S[kt][8 * s2 + 7] * rl);
            const bf16x8 pa = __builtin_bit_cast(bf16x8, pw);
#pragma unroll
            for (int nb = 0; nb < 4; ++nb) { const s16x4 lo = vtr(vb + nb * 2048 + s2 * 1024), hh = vtr(vb + nb * 2048 + s2 * 1024 + 512);
                const bf16x8 vf = (bf16x8){lo[0], lo[1], lo[2], lo[3], hh[0], hh[1], hh[2], hh[3]};
                O[nb] = __builtin_amdgcn_mfma_f32_32x32x16_bf16(pa, vf, O[nb], 0, 0, 0); } }
    }
#pragma unroll
    for (int g = 0; g < 16; ++g) { const int orow = (int)(row0 + ((size_t)(i0 + crow(g, hi)) << dsh));
#pragma unroll
        for (int nb = 0; nb < 4; ++nb) MIX[pg8::img_elem(orow, MIX_B + head * 128 + 32 * nb + r32, DM)] = (bf16)(cvt_pk_bf16(O[nb][g], 0.f) & 0xffffu); }
}

__device__ __forceinline__ void unpack8(const v4u& w, float (&f)[8]) { f[0] = bf_lo(w.x); f[1] = bf_hi(w.x); f[2] = bf_lo(w.y); f[3] = bf_hi(w.y); f[4] = bf_lo(w.z); f[5] = bf_hi(w.z); f[6] = bf_lo(w.w); f[7] = bf_hi(w.w); }
__device__ __forceinline__ void mixer_cd(const bf16* __restrict__ P, bf16* MIX, const float* __restrict__ cw  , unsigned gtid, unsigned nthr) {
    asm volatile("" : "+v"(gtid));
    constexpr int RUN = 16;
    for (unsigned it = gtid; it < (unsigned)(M / RUN) * 240u; it += nthr) {
        const unsigned run = it / 240u, ch = it - run * 240u; const int row0 = (int)run * RUN, t0 = row0 & (SEQ - 1);
        if (ch < 128u) {
            const int w = 2 << (ch >> 5); const bf16* p = P + (size_t)row0 * LDP + C_U + ch * 8; const int ocol = MIX_C + (int)ch * 8;
            float acc[8] = {0.f, 0.f, 0.f, 0.f, 0.f, 0.f, 0.f, 0.f};
            for (int i = 1; i < w; ++i) if (t0 - i >= 0) { float f[8]; unpack8(*(const v4u*)(p - (size_t)i * LDP), f);
#pragma unroll
                for (int e = 0; e < 8; ++e) acc[e] += f[e]; }
#pragma unroll 4
            for (int r = 0; r < RUN; ++r) { const int t = t0 + r; float cur[8]; unpack8(*(const v4u*)(p + (size_t)r * LDP), cur);
#pragma unroll
                for (int e = 0; e < 8; ++e) acc[e] += cur[e];
                const int cnt = (t + 1 < w) ? t + 1 : w; const float rc = 1.f / (float)cnt; v4u ov;
                ov.x = cvt_pk_bf16(acc[0] * rc - cur[0], acc[1] * rc - cur[1]); ov.y = cvt_pk_bf16(acc[2] * rc - cur[2], acc[3] * rc - cur[3]);
                ov.z = cvt_pk_bf16(acc[4] * rc - cur[4], acc[5] * rc - cur[5]); ov.w = cvt_pk_bf16(acc[6] * rc - cur[6], acc[7] * rc - cur[7]);
                *(v4u*)(MIX + pg8::img_elem(row0 + r, ocol, DM)) = ov;
                if (t - (w - 1) >= 0) { float f[8]; unpack8(*(const v4u*)(p + (size_t)(r - (w - 1)) * LDP), f);
#pragma unroll
                    for (int e = 0; e < 8; ++e) acc[e] -= f[e]; } }
        } else {
            const unsigned dc = ch - 128u; const bf16* pb = P + (size_t)row0 * LDP + C_GB + dc * 8; const bf16* pc = P + (size_t)row0 * LDP + C_GC + dc * 8; const bf16* ph = P + (size_t)row0 * LDP + C_HD + dc * 8;
            const int ocol = MIX_D + (int)dc * 8;
            float wk[3][8];
#pragma unroll
            for (int k = 0; k < 3; ++k) { const f32x4 a = *(const f32x4*)(cw + k * 896 + dc * 8), b = *(const f32x4*)(cw + k * 896 + dc * 8 + 4);
#pragma unroll
                for (int e = 0; e < 4; ++e) { wk[k][e] = a[e]; wk[k][4 + e] = b[e]; } }
            float z1[8], z2[8];
#pragma unroll
            for (int e = 0; e < 8; ++e) { z1[e] = 0.f; z2[e] = 0.f; }
            if (t0 >= 1) { float c[8], h[8]; unpack8(*(const v4u*)(pc - (size_t)LDP), c); unpack8(*(const v4u*)(ph - (size_t)LDP), h);
#pragma unroll
                for (int e = 0; e < 8; ++e) z1[e] = c[e] * h[e]; }
            if (t0 >= 2) { float c[8], h[8]; unpack8(*(const v4u*)(pc - (size_t)2 * LDP), c); unpack8(*(const v4u*)(ph - (size_t)2 * LDP), h);
#pragma unroll
                for (int e = 0; e < 8; ++e) z2[e] = c[e] * h[e]; }
#pragma unroll 4
            for (int r = 0; r < RUN; ++r) { float c[8], h[8], bb[8]; unpack8(*(const v4u*)(pc + (size_t)r * LDP), c); unpack8(*(const v4u*)(ph + (size_t)r * LDP), h); unpack8(*(const v4u*)(pb + (size_t)r * LDP), bb);
                float y[8];
#pragma unroll
                for (int e = 0; e < 8; ++e) { const float z0 = c[e] * h[e]; y[e] = bb[e] * (wk[0][e] * z2[e] + wk[1][e] * z1[e] + wk[2][e] * z0); z2[e] = z1[e]; z1[e] = z0; }
                v4u ov; ov.x = cvt_pk_bf16(y[0], y[1]); ov.y = cvt_pk_bf16(y[2], y[3]); ov.z = cvt_pk_bf16(y[4], y[5]); ov.w = cvt_pk_bf16(y[6], y[7]);
                *(v4u*)(MIX + pg8::img_elem(row0 + r, ocol, DM)) = ov; }
        }
    }
}

__device__ __forceinline__ void fix_rows(const bf16* __restrict__ OC, bf16* MIX, const float* __restrict__ LSE, const float* __restrict__ lamp  , const float* __restrict__ subln  ,
                                         float lam_init, int gw, int ngw, int lane) {
    asm volatile("" : "+v"(lane));
    const float lam = __expf(wave_sum(lamp[lane] * lamp[64 + lane])) - __expf(wave_sum(lamp[128 + lane] * lamp[192 + lane])) + lam_init;
    const float g0 = subln[2 * lane] * (1.f - lam_init), g1 = subln[2 * lane + 1] * (1.f - lam_init);
    for (int m0 = gw; m0 < M; m0 += 2 * ngw) {
        const int m1 = m0 + ngw; const bool has1 = m1 < M; const int mr[2] = {m0, has1 ? m1 : m0};
        unsigned a[2][8], b[2][8], mv[2][9]; float lv[2];
#pragma unroll
        for (int r = 0; r < 2; ++r) { const unsigned* oc = (const unsigned*)(OC + (size_t)mr[r] * LDOC);
#pragma unroll
            for (int h = 0; h < 8; ++h) { a[r][h] = oc[h * 128 + lane]; b[r][h] = oc[h * 128 + 64 + lane]; }
            lv[r] = LSE[(size_t)mr[r] * 16 + (lane < 9 ? lane : 0)];
#pragma unroll
            for (int q = 0; q < 9; ++q) mv[r][q] = *(const unsigned*)(MIX + pg8::img_elem(mr[r], MIX_B + q * 128 + 2 * lane, DM)); }
#pragma unroll
        for (int r = 0; r < 2; ++r) { if (r == 1 && !has1) break; const int m = mr[r];
#pragma unroll
            for (int h = 0; h < 8; ++h) {
                const float o0 = bf_lo(a[r][h]) - lam * bf_lo(b[r][h]), o1 = bf_hi(a[r][h]) - lam * bf_hi(b[r][h]);
                const float rn = 1.f / sqrtf(wave_sum(o0 * o0 + o1 * o1) * (1.f / 128.f) + 1e-5f);
                *(unsigned*)(MIX + pg8::img_elem(m, h * 128 + 2 * lane, DM)) = cvt_pk_bf16(o0 * rn * g0, o1 * rn * g1); }
#pragma unroll
            for (int hh = 0; hh < 3; ++hh) { const float l0 = __shfl(lv[r], hh), l1 = __shfl(lv[r], 3 + hh), l2 = __shfl(lv[r], 6 + hh), mm = fmaxf(l0, fmaxf(l1, l2));
                const float e0 = __builtin_amdgcn_exp2f(l0 - mm), e1 = __builtin_amdgcn_exp2f(l1 - mm), e2 = __builtin_amdgcn_exp2f(l2 - mm), inv = 1.f / (e0 + e1 + e2);
#pragma unroll
                for (int g = 0; g < 3; ++g) { const float al = (g == 0 ? e0 : (g == 1 ? e1 : e2)) * inv; const unsigned v = mv[r][3 * g + hh];
                    *(unsigned*)(MIX + pg8::img_elem(m, MIX_B + (3 * g + hh) * 128 + 2 * lane, DM)) = cvt_pk_bf16(bf_lo(v) * al, bf_hi(v) * al); } } }
    }
}

typedef const __attribute__((address_space(4))) Args* KArgs;
__device__ __forceinline__ KArgs kargs() { KArgs p = (KArgs)__builtin_amdgcn_kernarg_segment_ptr(); asm volatile("" : "+s"(p)); return p; }
#define ENV() \
    const KArgs ka = kargs(); unsigned char* const ws = ka->ws; \
    int tid = threadIdx.x; asm volatile("" : "+v"(tid)); \
    const int lane = tid & 63, wave = __builtin_amdgcn_readfirstlane(tid >> 6); \
    const int G = gridDim.x; volatile LAS unsigned* const MISCv = (volatile LAS unsigned*)(ldsp + MISC_OFF); \
    const int bx = MISCv[18] ? (int)(MISCv[17] * 8u + MISCv[16]) : (int)blockIdx.x;        \
    const int vcu = (G % 8 == 0) ? (bx % 8) * (G / 8) + bx / 8 : bx; \
    const unsigned gtid = (unsigned)vcu * 512u + (unsigned)tid, nthr = (unsigned)G * 512u; const int gw = vcu * NWAVES + wave, ngw = G * NWAVES; \
    (void)lane; (void)gtid; (void)nthr; (void)gw; (void)ngw; (void)bx; (void)ws
__global__ void __launch_bounds__(NWAVES * 64, 2) fwd(Args args_unused) {
    extern __shared__ __attribute__((aligned(16))) unsigned char lds[];
    LAS unsigned char* const ldsp = (LAS unsigned char*)lds;
    { const int tid0 = threadIdx.x; for (int u = tid0; u < (LDS_BYTES - LDSCTL_OFF) / 4; u += NWAVES * 64) ((LAS unsigned*)(ldsp + LDSCTL_OFF))[u] = 0u; }
    __syncthreads();
    int lo, hi; { const KArgs ka = kargs(); lo = ka->ph_lo; hi = ka->ph_hi; }
    if (threadIdx.x == 0) { unsigned* ctl0 = (unsigned*)(kargs()->ws + WS_CTL); const unsigned x = xb_xcc_id(); volatile LAS unsigned* Mv = (volatile LAS unsigned*)(ldsp + MISC_OFF);
        Mv[16] = x; Mv[17] = xb_add(&ctl0[CW_RANK + 64 * x], 1u); }
    __syncthreads();
    if (hi - lo > 1) { const KArgs ka = kargs(); (void)xcd_barrier_post((unsigned*)(ka->ws + WS_CTL) + CW_BAR, (volatile LAS unsigned*)(ldsp + MISC_OFF) + 8); }
#ifndef DUPMASK
#define DUPMASK 0
#endif
#define REP(b) for (int rep_ = 0; rep_ < (((DUPMASK >> (b)) & 1) ? 2 : 1); ++rep_)
#define IN(k) (lo <= (k) && (k) < hi)
#define SEAM(k) do { if (IN(k) && IN((k) + 1)) { XcdBarrier bar_; bar_.bar = (unsigned*)(kargs()->ws + WS_CTL) + CW_BAR; bar_.x = xb_xcc_id(); bar_.st = (volatile LAS unsigned*)(ldsp + MISC_OFF) + 8; xcd_barrier(bar_); } } while (0)

    if (IN(0)) { REP(0) { ENV(); p0_prologue(ka, ws, gtid, nthr, gw, ngw, lane, ldsp + RING_OFF + wave * 4096); } SEAM(0);
        if (IN(1)) {
            if (threadIdx.x == 0) { unsigned* ctl0 = (unsigned*)(kargs()->ws + WS_CTL); bool ok = gridDim.x == 256;
                for (unsigned x = 0; x < 16; ++x) ok = ok && xb_ld(&ctl0[CW_RANK + 64 * x]) == (x < 8 ? 32u : 0u);
                ((volatile LAS unsigned*)(ldsp + MISC_OFF))[18] = ok ? 1u : 0u; }
            __syncthreads(); } }
    if (IN(1)) {
        REP(1) { ENV(); pg8::Gemm g{(const bf16*)(ws + WS_PWT), (const bf16*)(ws + WS_WUNT), 2048, DM, 256, 256, (size_t)DM * 256 * 2}; pg8::StaticOrder S; S.init(2048, DM, G, bx);
          pg8::EpiFold E{(bf16*)(ws + WS_W + W_IN), W_LAYER / 2};
          pg8::gemm_phase<pg8::EpiFold, pg8::StaticOrder, true>(ldsp + RING_OFF, g, S, E); }
        SEAM(1);
    }
    for (int l = 0; l < DEPTH; ++l) {
        const int pb = 2 + 6 * l;
        if (IN(pb)) {
            REP(2) { ENV(); pg8::Gemm g{(const bf16*)(ws + WS_HN), (const bf16*)(ws + WS_W + (size_t)l * W_LAYER + W_IN), M, NIN, DM, LDH, 0}; pg8::StaticOrder S; S.init(M, NIN, G, bx);
              pg8::EpiProj E{(bf16*)(ws + WS_PROJ), (const float*)(ws + WS_COSA), (const float*)(ws + WS_SINA), (const float*)(ws + WS_COSB), (const float*)(ws + WS_SINB), (const pg8::ss_t*)(ws + WS_SS) + l * M};
              pg8::gemm_phase<pg8::EpiProj, pg8::StaticOrder, true>(ldsp + RING_OFF, g, S, E); }
            SEAM(pb);
        }
        if (IN(pb + 1)) {
            REP(3) { ENV(); attn128::attn_phase((char*)lds + RING_OFF, (const attn128::bf16*)(ws + WS_PROJ), (attn128::bf16*)(ws + WS_OC), vcu, G); }
            REP(4) { ENV(); for (int T = gw; T < 2 * 9 * 128; T += ngw) dil_tile((const bf16*)(ws + WS_PROJ), (bf16*)(ws + WS_MIX), (float*)(ws + WS_LSE), T, (LAS char*)(ldsp + RING_OFF + wave * 8192), lane); }
            REP(5) { ENV(); mixer_cd((const bf16*)(ws + WS_PROJ), (bf16*)(ws + WS_MIX), ka->in[9] + l * 3 * 896, gtid, nthr); }
            SEAM(pb + 1);
        }
        if (IN(pb + 2)) {
            { ENV(); const float lam_init = 0.8f - 0.6f * __expf(-0.3f * (float)l);
              fix_rows((const bf16*)(ws + WS_OC), (bf16*)(ws + WS_MIX), (const float*)(ws + WS_LSE), ka->in[5] + l * 256, ka->in[6] + l * 128, lam_init, gw, ngw, lane); }
            SEAM(pb + 2);
        }
        if (IN(pb + 3)) {
            { ENV(); pg8::Gemm g{(const bf16*)(ws + WS_MIX), (const bf16*)(ws + WS_W + (size_t)l * W_LAYER + W_OUT), M, DM, DM, LDMX, 0}; pg8::StaticOrder S; S.init(M, DM, G, bx);
              pg8::EpiRes E{(bf16*)(ws + WS_HN), LDH, (pg8::ss_t*)(ws + WS_SS) + (DEPTH + l) * M, nullptr, DM};
              pg8::gemm_phase<pg8::EpiRes, pg8::StaticOrder, true>(ldsp + RING_OFF, g, S, E); }
#if defined(PROBE_OUT2)
            { ENV(); pg8::Gemm g{(const bf16*)(ws + WS_MIX), (const bf16*)(ws + WS_W + (size_t)l * W_LAYER + W_OUT), M, DM, DM, LDMX, 0}; pg8::StaticOrder S; S.init(M, DM, G, bx);
              pg8::EpiRes E{(bf16*)(ws + WS_HN), LDH, nullptr, (float*)(ws + WS_ACT), DM};
              pg8::gemm_phase<pg8::EpiRes, pg8::StaticOrder, true, PROBE_OUT2>(ldsp + RING_OFF, g, S, E); }
#endif
            SEAM(pb + 3);
        }
        if (IN(pb + 4)) {
            REP(8) { ENV(); pg8::Gemm g{(const bf16*)(ws + WS_HN), (const bf16*)(ws + WS_W + (size_t)l * W_LAYER + W_UP), M, DFF, DM, LDH, 0}; pg8::StaticOrder S; S.init(M, DFF, G, bx);
              pg8::EpiRelu2 E{(bf16*)(ws + WS_ACT), LDACT, (const pg8::ss_t*)(ws + WS_SS) + (DEPTH + l) * M};
              pg8::gemm_phase<pg8::EpiRelu2, pg8::StaticOrder, true>(ldsp + RING_OFF, g, S, E); }
#if defined(PROBE_UP2)
            { ENV(); pg8::Gemm g{(const bf16*)(ws + WS_HN), (const bf16*)(ws + WS_W + (size_t)l * W_LAYER + W_UP), M, DFF, DM, LDH, 0}; pg8::StaticOrder S; S.init(M, DFF, G, bx);
              pg8::EpiRelu2 E{(bf16*)(ws + WS_PROJ), LDACT, (const pg8::ss_t*)(ws + WS_SS) + (DEPTH + l) * M};
              pg8::gemm_phase<pg8::EpiRelu2, pg8::StaticOrder, true, PROBE_UP2, PROBE_UP2B>(ldsp + RING_OFF, g, S, E); }
#endif
            SEAM(pb + 4);
        }
        if (IN(pb + 5)) {
            { ENV(); pg8::Gemm g{(const bf16*)(ws + WS_ACT), (const bf16*)(ws + WS_W + (size_t)l * W_LAYER + W_DN), M, DM, DFF, LDACT, 0}; pg8::StaticOrder S; S.init(M, DM, G, bx);
              pg8::EpiRes E{(bf16*)(ws + WS_HN), LDH, (pg8::ss_t*)(ws + WS_SS) + (l + 1 < DEPTH ? l + 1 : 2 * DEPTH) * M, nullptr, DM};
              pg8::gemm_phase<pg8::EpiRes, pg8::StaticOrder, true>(ldsp + RING_OFF, g, S, E); }
#if defined(PROBE_DN2)
            { ENV(); pg8::Gemm g{(const bf16*)(ws + WS_ACT), (const bf16*)(ws + WS_W + (size_t)l * W_LAYER + W_DN), M, DM, DFF, LDACT, 0}; pg8::StaticOrder S; S.init(M, DM, G, bx);
              pg8::EpiRes E{(bf16*)(ws + WS_HN), LDH, nullptr, (float*)(ws + WS_PROJ), DM};
              pg8::gemm_phase<pg8::EpiRes, pg8::StaticOrder, true, PROBE_DN2>(ldsp + RING_OFF, g, S, E); }
#endif
            SEAM(pb + 5);
        }
    }
    if (IN(N_PHASES - 1)) { ENV(); rmsnorm_final((const bf16*)(ws + WS_HN), (const pg8::ss_t*)(ws + WS_SS) + 2 * DEPTH * M, ka->out, ka->in[12], gw, ngw, lane); }
#undef IN
#undef SEAM
#undef ENV
#undef REP
}

extern "C" void kernel_launch(void* const* d_in, const int* in_sizes, int n_in, void* d_out, int out_size, void* d_ws, size_t ws_size, hipStream_t stream) {
    static int grid = 0;
    if (grid == 0) {
        if (n_in != 13 || in_sizes[0] != M * DM || out_size != M * DM || ws_size < WS_END) { fprintf(stderr, "kernel_launch: unexpected shapes / workspace (n_in %d, in0 %d, out %d, ws %zu < %zu); nothing launched\n", n_in, n_in > 0 ? in_sizes[0] : -1, out_size, ws_size, (size_t)WS_END); grid = -1; return; }
        int dev = 0, cus = 0, per_cu = 0;
        if (hipGetDevice(&dev) != hipSuccess || hipDeviceGetAttribute(&cus, hipDeviceAttributeMultiprocessorCount, dev) != hipSuccess) { fprintf(stderr, "kernel_launch: device query failed\n"); grid = -1; return; }
        if (hipFuncSetAttribute((const void*)fwd, hipFuncAttributeMaxDynamicSharedMemorySize, LDS_BYTES) != hipSuccess) { fprintf(stderr, "kernel_launch: hipFuncSetAttribute failed\n"); grid = -1; return; }
        if (hipOccupancyMaxActiveBlocksPerMultiprocessor(&per_cu, (const void*)fwd, NWAVES * 64, LDS_BYTES) != hipSuccess || per_cu < 1) fprintf(stderr, "kernel_launch: note: occupancy query reports %d workgroups per CU\n", per_cu);
        (void)hipGetLastError();
        grid = cus;
    }
    if (grid < 0) return;
    if (hipMemsetAsync((char*)d_ws + WS_CTL, 0, CTL_ZERO_BYTES, stream) != hipSuccess) { fprintf(stderr, "kernel_launch: hipMemsetAsync failed\n"); return; }
    Args a{};
    for (int i = 0; i < 13; ++i) a.in[i] = (const float*)d_in[i];
    a.out = (float*)d_out; a.ws = (unsigned char*)d_ws;
#if MK_SPLIT
    for (int p = 0; p < N_PHASES; ++p) { a.ph_lo = p; a.ph_hi = p + 1; hipLaunchKernelGGL(fwd, dim3(grid), dim3(NWAVES * 64), LDS_BYTES, stream, a); }
#else
    a.ph_lo = 0; a.ph_hi = N_PHASES; hipLaunchKernelGGL(fwd, dim3(grid), dim3(NWAVES * 64), LDS_BYTES, stream, a);
#endif
    const hipError_t le = hipPeekAtLastError();
    if (le != hipSuccess) fprintf(stderr, "kernel_launch: launch failed: %s\n", hipGetErrorName(le));
}
```

```cpp
#include <hip/hip_runtime.h>
#include <hip/hip_bf16.h>
#include <cstdio>
#include <cstdint>
#include <cmath>

constexpr int BATCH = 2, SEQ = 4096, DM = 4096, M = BATCH * SEQ, NIN = 10240, DFF = 16384, DEPTH = 2;
constexpr int C_QA = 0, C_KA = 1024, C_VA = 2048, C_QB = 3072, C_KB = 4224, C_VB = 5376, C_U = 6528, C_GB = 7552, C_GC = 8448, C_HD = 9344;
constexpr int LDH = DM, LDP = NIN, LDMX = DM, LDOC = 2048, LDACT = DFF;
constexpr int MIX_A = 0, MIX_B = 1024, MIX_C = 2176, MIX_D = 3200;
constexpr float LOG2E = 1.4426950408889634f;
constexpr float SC_A = 0.125f * LOG2E;
constexpr float SC_B = 0.08838834764831845f * LOG2E;

namespace pg8 {
#define PG8_LAS __attribute__((address_space(3)))
typedef unsigned short bf16_t;
typedef short bf16x8 __attribute__((ext_vector_type(8)));
typedef float f32x4 __attribute__((ext_vector_type(4)));
typedef float f32x2 __attribute__((ext_vector_type(2)));
typedef unsigned u32x4 __attribute__((ext_vector_type(4)));
typedef unsigned long long ss_t;
constexpr float SS_SCALE = 16777216.f, SS_INV = 1.f / 16777216.f;
constexpr int BM = 256, BK = 64, HALF = 128, HTB = HALF * BK * 2  , STAGE_BYTES = 8 * HTB, NXCD = 8, WGM = 4;

__host__ __device__ __forceinline__ int lds_byte(int r, int c) { const int st = (r >> 4) * 2 + (c >> 5), rr = r & 15, cc = c & 31, ob = rr * 64 + cc * 2; return st * 1024 + (ob ^ (((ob >> 9) & 1) << 5)); }
__host__ __device__ __forceinline__ void stage_rc(int b, int& R, int& C) { const int st = b / 1024, sb = b % 1024, swz = sb ^ (((sb >> 9) & 1) << 5); R = (st >> 1) * 16 + swz / 64; C = (st & 1) * 32 + (swz % 64) / 2; }
__host__ __device__ __forceinline__ int perm32(int rho) { const int n = rho >> 4, i = rho & 15; return 8 * (i >> 2) + 4 * n + (i & 3); }

__host__ __device__ __forceinline__ size_t img_elem(int r, int c, int K) { const int ob = (r & 15) * 64 + (c & 31) * 2; return ((size_t)((r >> 4) * (K >> 5) + (c >> 5)) * 1024 + (size_t)(ob ^ (((ob >> 9) & 1) << 5))) >> 1; }
__host__ __device__ __forceinline__ int p32inv(int s) { return 16 * ((s >> 2) & 1) + 4 * (s >> 3) + (s & 3); }
__host__ __device__ __forceinline__ int brow(int np) { return (np & ~31) + p32inv(np & 31); }
__device__ __forceinline__ unsigned epi_img_base(int pm, int pn, int wr, int wc, int fr, int fq, int K) {
    return (unsigned)((16 * pm + 4 * wr) * (K >> 5) + 8 * pn + wc) * 512u + (unsigned)(fr * 64 + ((16 * fq) ^ ((fr & 8) << 2))) / 2u; }
struct Unit { int pm, pn; };
struct Gemm { const bf16_t* A; const bf16_t* Bt; int M, N, K, lda; size_t b_pm_stride; };

struct StaticOrder {
    int nM, nN, nwg, G, c;
    __host__ __device__ void init(int M_, int N_, int G_, int c_) { nM = M_ / BM; nN = N_ / BM; nwg = nM * nN; G = G_; c = c_; }
    __host__ __device__ bool next(int i, Unit& u) const {
        const long L = (long)i * G + c; if (L >= nwg) return false;
        int wgid = (int)L; { const int q = nwg / NXCD, r = nwg % NXCD, xcd = wgid % NXCD, off = wgid / NXCD; wgid = (xcd < r ? xcd * (q + 1) : r * (q + 1) + (xcd - r) * q) + off; }
        const int nig = WGM * nN, gid = wgid / nig, fm = gid * WGM, gsz = (nM - fm) < WGM ? (nM - fm) : WGM;
        u.pm = fm + ((wgid % nig) % gsz); u.pn = (wgid % nig) / gsz; return true;
    }
};

typedef __bf16 bf16x2_t __attribute__((ext_vector_type(2)));
__device__ __forceinline__ unsigned cvt_pk_bf16(float lo, float hi) { f32x2 v = {lo, hi}; bf16x2_t b = __builtin_convertvector(v, bf16x2_t); return __builtin_bit_cast(unsigned, b); }
__device__ __forceinline__ u32x4 pack8(const f32x4& a, const f32x4& b) { u32x4 w; w.x = cvt_pk_bf16(a[0], a[1]); w.y = cvt_pk_bf16(a[2], a[3]); w.z = cvt_pk_bf16(b[0], b[1]); w.w = cvt_pk_bf16(b[2], b[3]); return w; }

struct EpiProj {
    static constexpr bool PERM = true;
    bf16_t* O; const float* cosA; const float* sinA; const float* cosB; const float* sinB; const ss_t* ss;
    __device__ __forceinline__ void operator()(const f32x4 (&acc)[2][2][4][2], const Unit& u, int wr, int wc, int fr, int fq) const {
        const int pn = u.pn, row0 = u.pm * BM + wr * 64 + fr;
        float rs[2][4];
#pragma unroll
        for (int ai = 0; ai < 2; ++ai)
#pragma unroll
            for (int m = 0; m < 4; ++m) rs[ai][m] = 1.f / sqrtf((float)ss[row0 + ai * HALF + m * 16] * (SS_INV / DM) + 1e-6f);
        const int type = pn < 8 ? 1 : ((pn >= 12 && pn <= 20) ? 2 : 0);
        if (type == 0) {
            const int col0 = pn * BM + wc * 32 + 8 * fq;
#pragma unroll
            for (int ai = 0; ai < 2; ++ai)
#pragma unroll
                for (int m = 0; m < 4; ++m) { bf16_t* rowp = O + (size_t)(row0 + ai * HALF + m * 16) * LDP + col0;
#pragma unroll
                    for (int bj = 0; bj < 2; ++bj) *(u32x4*)(rowp + bj * HALF) = pack8(acc[ai][bj][m][0] * rs[ai][m], acc[ai][bj][m][1] * rs[ai][m]); }
        } else {
            float sc; int i0, d1, dd, tp; const float *ct, *st;
            if (type == 1) { sc = pn < 4 ? SC_A : 1.f; i0 = 8 * fq; d1 = pn * BM + 64 * wc + i0; dd = 32; tp = 32; ct = cosA; st = sinA; }
            else { const bool isq = (pn < 16) || (pn == 16 && wc < 2); sc = isq ? SC_B : 1.f; i0 = 32 * (wc & 1) + 8 * fq; d1 = pn * BM + 128 * (wc >> 1) + i0; dd = 64; tp = 64; ct = cosB; st = sinB; }
#pragma unroll
            for (int ai = 0; ai < 2; ++ai)
#pragma unroll
                for (int m = 0; m < 4; ++m) { const int row = row0 + ai * HALF + m * 16, pos = row & (SEQ - 1); const float scr = sc * rs[ai][m];
                    const f32x4 c0 = *(const f32x4*)(ct + pos * tp + i0), c1 = *(const f32x4*)(ct + pos * tp + i0 + 4), s0 = *(const f32x4*)(st + pos * tp + i0), s1 = *(const f32x4*)(st + pos * tp + i0 + 4);
                    const f32x4 x10 = acc[ai][0][m][0], x11 = acc[ai][0][m][1], x20 = acc[ai][1][m][0], x21 = acc[ai][1][m][1];
                    const f32x4 a0 = (x10 * c0 - x20 * s0) * scr, a1 = (x11 * c1 - x21 * s1) * scr, b0 = (x10 * s0 + x20 * c0) * scr, b1 = (x11 * s1 + x21 * c1) * scr;
                    bf16_t* rowp = O + (size_t)row * LDP + d1;
                    *(u32x4*)(rowp) = pack8(a0, a1); *(u32x4*)(rowp + dd) = pack8(b0, b1); }
        }
    }
};
struct EpiRelu2 {
    static constexpr bool PERM = true;
    bf16_t* O; int Kact; const ss_t* ss;
    __device__ __forceinline__ void operator()(const f32x4 (&acc)[2][2][4][2], const Unit& u, int wr, int wc, int fr, int fq) const {
        const int row0 = u.pm * BM + wr * 64 + fr; const unsigned base = epi_img_base(u.pm, u.pn, wr, wc, fr, fq, Kact); const unsigned kb = (unsigned)(Kact >> 5) * 512u;
#pragma unroll
        for (int ai = 0; ai < 2; ++ai)
#pragma unroll
            for (int m = 0; m < 4; ++m) { const float r2 = 1.f / ((float)ss[row0 + ai * HALF + m * 16] * (SS_INV / DM) + 1e-6f);
#pragma unroll
                for (int bj = 0; bj < 2; ++bj) { f32x4 v0 = acc[ai][bj][m][0], v1 = acc[ai][bj][m][1];
                    v0 = __builtin_elementwise_max(v0, (f32x4){0.f, 0.f, 0.f, 0.f}); v1 = __builtin_elementwise_max(v1, (f32x4){0.f, 0.f, 0.f, 0.f}); v0 = v0 * v0 * r2; v1 = v1 * v1 * r2;
                    *(u32x4*)(O + (size_t)(base + (unsigned)(8 * ai + m) * kb + (unsigned)(4 * bj) * 512u)) = pack8(v0, v1); } }
    }
};
struct EpiRes {
    static constexpr bool PERM = true;
    bf16_t* xb; int ldh; ss_t* ss; float* outf; int ldc;
    __device__ __forceinline__ void operator()(const f32x4 (&acc)[2][2][4][2], const Unit& u, int wr, int wc, int fr, int fq) const {
        const int row0 = u.pm * BM + wr * 64 + fr, col0 = u.pn * BM + wc * 32 + 8 * fq; const bool LAST = outf != nullptr; const unsigned base = epi_img_base(u.pm, u.pn, wr, wc, fr, fq, DM);
#pragma unroll
        for (int ai = 0; ai < 2; ++ai)
#pragma unroll
            for (int m = 0; m < 4; ++m) { const int row = row0 + ai * HALF + m * 16; float sq = 0.f;
#pragma unroll
                for (int bj = 0; bj < 2; ++bj) { bf16_t* xp = xb + (size_t)(base + (unsigned)(8 * ai + m) * (unsigned)(DM / 32) * 512u + (unsigned)(4 * bj) * 512u); const u32x4 w = *(const u32x4*)xp;
                    const f32x4 r0 = {__uint_as_float(w.x << 16), __uint_as_float(w.x & 0xffff0000u), __uint_as_float(w.y << 16), __uint_as_float(w.y & 0xffff0000u)};
                    const f32x4 r1 = {__uint_as_float(w.z << 16), __uint_as_float(w.z & 0xffff0000u), __uint_as_float(w.w << 16), __uint_as_float(w.w & 0xffff0000u)};
                    const f32x4 x0 = r0 + acc[ai][bj][m][0], x1 = r1 + acc[ai][bj][m][1];
                    if (LAST) { float* op = outf + (size_t)row * ldc + col0 + bj * HALF; *(f32x4*)op = x0; *(f32x4*)(op + 4) = x1; }
                    else { *(u32x4*)xp = pack8(x0, x1);
                        sq += (x0[0] * x0[0] + x0[1] * x0[1]) + (x0[2] * x0[2] + x0[3] * x0[3]) + (x1[0] * x1[0] + x1[1] * x1[1]) + (x1[2] * x1[2] + x1[3] * x1[3]); } }
                if (!LAST) { sq += __shfl_xor(sq, 16); sq += __shfl_xor(sq, 32); if (fq == 0) atomicAdd(ss + row, (ss_t)(sq * SS_SCALE)); } }
    }
};
struct EpiFold {
    static constexpr bool PERM = true;
    bf16_t* W0; size_t layer_stride;
    __device__ __forceinline__ void operator()(const f32x4 (&acc)[2][2][4][2], const Unit& u, int wr, int wc, int fr, int fq) const {
        bf16_t* W = W0 + (size_t)(u.pm >> 2) * layer_stride; const int n0 = C_U + (u.pm & 3) * 256 + wr * 64;
        const unsigned rb0 = (unsigned)(n0 >> 4) + ((fr >> 2) & 1), rl = 4 * (fr >> 3) + (fr & 3), cb0 = (unsigned)(u.pn * 8 + wc);
        const unsigned base_e = (rb0 * (DM / 32) + cb0) * 512u + (rl * 64u + 16u * fq) / 2u, base_o = (rb0 * (DM / 32) + cb0) * 512u + ((rl + 8u) * 64u + 16u * (fq ^ 2)) / 2u;
#pragma unroll
        for (int ai = 0; ai < 2; ++ai)
#pragma unroll
            for (int m = 0; m < 4; ++m)
#pragma unroll
                for (int bj = 0; bj < 2; ++bj) { const unsigned off = ((m & 1) ? base_o : base_e) + (unsigned)((8 * ai + 2 * (m >> 1)) * (DM / 32) + 4 * bj) * 512u;
                    *(u32x4*)(W + off) = pack8(acc[ai][bj][m][0], acc[ai][bj][m][1]); }
    }
};

template <class Epi, class Sched, bool ALIGN_EPI, int LMASK = -1, int LMASKB = LMASK>
__device__ __forceinline__ void gemm_phase(PG8_LAS unsigned char* lds, const Gemm g, const Sched& S, const Epi& E) {
    int tid = threadIdx.x; asm volatile("" : "+v"(tid));
    const int wid = __builtin_amdgcn_readfirstlane(tid >> 6), lane = tid & 63, wr = wid >> 2, wc = wid & 3, fr = lane & 15, fq = lane >> 4;
    const int K = g.K, nt = K / BK;
    unsigned voffA[2], voffB[2];
#pragma unroll
    for (int i = 0; i < 2; ++i) { int R, C; stage_rc(tid * 16 + i * 8192, R, C); const int Rb = Epi::PERM ? ((R & ~31) + perm32(R & 31)) : R;
        voffB[i] = (unsigned)(((R >> 4) * (K / 32) + (C >> 5)) * 1024 + ((tid * 16) & 1023)); voffA[i] = voffB[i]; (void)Rb; }
    const size_t kstepA = (size_t)2048, hstepA = (size_t)HALF * K * 2, tstepA = 2 * hstepA;
    const size_t kstepB = (size_t)2048, hstepB = (size_t)HALF * K * 2, tstepB = 2 * hstepB;
    const unsigned ldsw = (unsigned)wid * 1024u;
    const int aoff = lds_byte(wr * 64 + fr, fq * 8), boff = lds_byte(wc * 32 + fr, fq * 8);
#define PG8_SA(b, h) (((b) * 2 + (h)) * HTB)
#define PG8_SB(b, h) ((4 + (b) * 2 + (h)) * HTB)
#define PG8_STAGE(bufoff, gbase, voff) do { _Pragma("unroll") for (int _i = 0; _i < 2; ++_i) \
        __builtin_amdgcn_global_load_lds((const unsigned*)((const char*)(gbase) + (voff)[_i]), (PG8_LAS unsigned*)(lds + (bufoff) + ldsw + _i * 8192), 16, 0, 0); } while (0)
#define PG8_LDA(dst, b, h) do { _Pragma("unroll") for (int m = 0; m < 4; ++m) _Pragma("unroll") for (int k = 0; k < 2; ++k) dst[m][k] = *(const PG8_LAS bf16x8*)(lds + PG8_SA(b, h) + aoff + m * 2048 + k * 1024); } while (0)
#define PG8_LDB(dst, b, h) do { _Pragma("unroll") for (int n = 0; n < 2; ++n) _Pragma("unroll") for (int k = 0; k < 2; ++k) dst[n][k] = *(const PG8_LAS bf16x8*)(lds + PG8_SB(b, h) + boff + n * 2048 + k * 1024); } while (0)
#define PG8_MMA(ai, bj, At, Bt) do { __builtin_amdgcn_s_setprio(1); _Pragma("unroll") for (int m = 0; m < 4; ++m) _Pragma("unroll") for (int n = 0; n < 2; ++n) _Pragma("unroll") for (int k = 0; k < 2; ++k) \
        acc[ai][bj][m][n] = __builtin_amdgcn_mfma_f32_16x16x32_bf16(Bt[n][k], At[m][k], acc[ai][bj][m][n], 0, 0, 0); __builtin_amdgcn_s_setprio(0); } while (0)
#define PG8_WAIT_V(n) asm volatile("s_waitcnt vmcnt(" #n ")" ::: "memory")
#define PG8_WAIT_L(n) asm volatile("s_waitcnt lgkmcnt(" #n ")" ::: "memory")
#define PG8_BAR __builtin_amdgcn_s_barrier()
#define PG8_SCHED __builtin_amdgcn_sched_barrier(0)
    Unit cur, nxt; int ui = 0;
    if (!S.next(0, cur)) return;
    f32x4 acc[2][2][4][2];
#pragma unroll
    for (int a = 0; a < 2; ++a)
#pragma unroll
        for (int b = 0; b < 2; ++b)
#pragma unroll
            for (int m = 0; m < 4; ++m)
#pragma unroll
                for (int n = 0; n < 2; ++n) acc[a][b][m][n] = (f32x4){0.f, 0.f, 0.f, 0.f};
    bf16x8 At[4][2], B0[2][2], B1[2][2];
    const char* cA = (const char*)g.A + (size_t)(cur.pm & LMASK) * tstepA; const char* cB = (const char*)g.Bt + (size_t)cur.pm * g.b_pm_stride + (size_t)(cur.pn & LMASKB) * tstepB;
    PG8_STAGE(PG8_SB(0, 0), cB, voffB); PG8_STAGE(PG8_SB(0, 1), cB + hstepB, voffB); PG8_STAGE(PG8_SA(0, 0), cA, voffA); PG8_STAGE(PG8_SA(0, 1), cA + hstepA, voffA);
    if (wr == 1) PG8_BAR;
    PG8_WAIT_V(2); PG8_BAR;
    PG8_STAGE(PG8_SB(1, 0), cB + kstepB, voffB); PG8_STAGE(PG8_SA(1, 0), cA + kstepA, voffA); PG8_STAGE(PG8_SB(1, 1), cB + hstepB + kstepB, voffB);
    PG8_WAIT_V(6); PG8_BAR;
    for (;;) {
        const bool has_next = S.next(ui + 1, nxt);
        const char* nA = has_next ? (const char*)g.A + (size_t)(nxt.pm & LMASK) * tstepA : cA; const char* nB = has_next ? (const char*)g.Bt + (size_t)nxt.pm * g.b_pm_stride + (size_t)(nxt.pn & LMASKB) * tstepB : cB;
        for (int t = 0; t < nt; t += 2) {
            const bool last = (t == nt - 2);
            const char* a1 = cA + (size_t)(t + 1) * kstepA;
            const char* a2 = last ? nA : cA + (size_t)(t + 2) * kstepA; const char* b2 = last ? nB : cB + (size_t)(t + 2) * kstepB;
            const char* a3 = a2 + kstepA; const char* b3 = b2 + kstepB;
            PG8_LDB(B0, 0, 0); PG8_LDB(B1, 0, 1); PG8_SCHED; PG8_LDA(At, 0, 0); PG8_STAGE(PG8_SA(1, 1), a1 + hstepA, voffA);
            PG8_WAIT_V(8); PG8_WAIT_L(0); PG8_BAR; PG8_MMA(0, 0, At, B0); PG8_MMA(0, 1, At, B1); PG8_BAR; PG8_SCHED;
            PG8_LDA(At, 0, 1); PG8_STAGE(PG8_SB(0, 0), b2, voffB); PG8_STAGE(PG8_SB(0, 1), b2 + hstepB, voffB); PG8_STAGE(PG8_SA(0, 0), a2, voffA);
            PG8_WAIT_V(8); PG8_WAIT_L(0); PG8_BAR; PG8_MMA(1, 0, At, B0); PG8_MMA(1, 1, At, B1); PG8_BAR; PG8_SCHED;
            PG8_LDB(B0, 1, 0); PG8_LDB(B1, 1, 1); PG8_SCHED; PG8_LDA(At, 1, 0); PG8_STAGE(PG8_SA(0, 1), a2 + hstepA, voffA);
            PG8_WAIT_V(8); PG8_WAIT_L(0); PG8_BAR; PG8_MMA(0, 0, At, B0); PG8_MMA(0, 1, At, B1); PG8_BAR; PG8_SCHED;
            PG8_LDA(At, 1, 1); PG8_STAGE(PG8_SB(1, 0), b3, voffB); PG8_STAGE(PG8_SB(1, 1), b3 + hstepB, voffB); PG8_STAGE(PG8_SA(1, 0), a3, voffA);
            PG8_WAIT_V(8); PG8_WAIT_L(0); PG8_BAR; PG8_MMA(1, 0, At, B0); PG8_MMA(1, 1, At, B1); PG8_BAR; PG8_SCHED;
        }
        if constexpr (ALIGN_EPI) { if (wr == 0) PG8_BAR; }
        E(acc, cur, wr, wc, fr, fq);
        if (!has_next) break;
#pragma unroll
        for (int a = 0; a < 2; ++a)
#pragma unroll
            for (int b = 0; b < 2; ++b)
#pragma unroll
                for (int m = 0; m < 4; ++m)
#pragma unroll
                    for (int n = 0; n < 2; ++n) acc[a][b][m][n] = (f32x4){0.f, 0.f, 0.f, 0.f};
        cur = nxt; cA = nA; cB = nB; ++ui;
        if constexpr (ALIGN_EPI) { if (wr == 1) PG8_BAR; }
    }
    PG8_WAIT_V(0);
    if constexpr (!ALIGN_EPI) { if (wr == 0) PG8_BAR; }
    PG8_BAR;
#undef PG8_SA
#undef PG8_SB
#undef PG8_STAGE
#undef PG8_LDA
#undef PG8_LDB
#undef PG8_MMA
#undef PG8_WAIT_V
#undef PG8_WAIT_L
#undef PG8_BAR
#undef PG8_SCHED
}
}
namespace attn128 {
using bf16 = __hip_bfloat16;
typedef short bf16x8 __attribute__((ext_vector_type(8)));
typedef short s16x4 __attribute__((ext_vector_type(4)));
typedef float f32x16 __attribute__((ext_vector_type(16)));
typedef float f32x4 __attribute__((ext_vector_type(4)));
typedef unsigned u32x4 __attribute__((ext_vector_type(4)));
constexpr int D = 128, DK = 64, NW = 8, QBLK = 32, KVBLK = 64, QB = NW * QBLK;
constexpr int QS = ::LDP, KS = ::LDP, VS = ::LDP, OS = ::LDOC;
constexpr int SHM_V = KVBLK * D * 2, SHM_K = KVBLK * D * 2;
constexpr int LDS_BYTES = 2 * SHM_V + 2 * SHM_K + NW * 64 * 4;
constexpr float THR = 11.5f;
#ifndef ATT_NOPRIO
#define ATT_PRIO(x) __builtin_amdgcn_s_setprio(x)
#else
#define ATT_PRIO(x)
#endif
#define KSWZ(row, colB) ((row) * 256 + ((colB) ^ (((row) & 15) << 4)))
#define SBAR() __builtin_amdgcn_sched_barrier(0)
__device__ __forceinline__ int v_st(int k, int c) { const int kk = (k & ~0xC) | ((k & 4) << 1) | ((k & 8) >> 1); return ((kk >> 3) * 4 + (c >> 5)) * 512 + ((kk & 7) * 32 + (c & 31)) * 2; }
__device__ __forceinline__ int v_rd_base(int lane) { return ((lane & 3) << 3) | (((lane >> 2) & 3) << 6) | (((lane >> 4) & 1) << 5) | (((lane >> 5) & 1) << 8); }
constexpr int v_rd_off(int d0, int ks, int half) { return d0 * 512 + ks * 4096 + half * 2048; }
__device__ __forceinline__ int crow(int r, int hi) { return (r & 3) + 8 * (r >> 2) + 4 * hi; }
__device__ __forceinline__ unsigned cvtpk(float lo, float hi) { unsigned r; asm volatile("v_cvt_pk_bf16_f32 %0, %1, %2" : "=v"(r) : "v"(lo), "v"(hi)); return r; }
__device__ __forceinline__ unsigned cvtpk_b(float lo, float hi) { typedef float f2_ __attribute__((ext_vector_type(2))); typedef __bf16 b2_ __attribute__((ext_vector_type(2))); f2_ v = {lo, hi}; return __builtin_bit_cast(unsigned, __builtin_convertvector(v, b2_)); }
__device__ __forceinline__ bf16x8 load8(const bf16* p) { return *reinterpret_cast<const bf16x8*>(p); }
__device__ __forceinline__ void mask_tile(f32x16& p0, f32x16& p1, int dq) {
    const float NEG = -__builtin_inff();
#pragma unroll
    for (int r = 0; r < 16; ++r) { const int c = (r & 3) + 8 * (r >> 2);
        if (dq - c < 0) p0[r] = NEG;
        if (dq - c - 32 < 0) p1[r] = NEG; }
}
__device__ __forceinline__ void partialSM(f32x16& p0, f32x16& p1, float& m_reg, float& mn, float& alpha) {
    float pmax = p0[0]; for (int r = 1; r < 16; ++r) pmax = fmaxf(pmax, p0[r]); for (int r = 0; r < 16; ++r) pmax = fmaxf(pmax, p1[r]);
    { auto rr = __builtin_amdgcn_permlane32_swap(__float_as_uint(pmax), __float_as_uint(pmax), false, false);
      pmax = fmaxf(__uint_as_float(rr[0]), __uint_as_float(rr[1])); }
    if (__builtin_expect(__all((pmax - m_reg) <= THR), 1)) { mn = m_reg; alpha = 1.f; }
    else { mn = fmaxf(m_reg, pmax); alpha = __builtin_amdgcn_exp2f(m_reg - mn); m_reg = mn; }
    for (int r = 0; r < 16; ++r) p0[r] = p0[r] - mn; for (int r = 0; r < 16; ++r) p1[r] = p1[r] - mn;
    for (int r = 0; r < 16; ++r) p0[r] = __builtin_amdgcn_exp2f(p0[r]);
}
__device__ __forceinline__ void finishSM(f32x16& p0, f32x16& p1, bf16x8& pa0, bf16x8& pa1, bf16x8& pa2, bf16x8& pa3) {
    for (int r = 0; r < 16; ++r) p1[r] = __builtin_amdgcn_exp2f(p1[r]);
#define PK4(P, B_, OUT) do { unsigned a0 = cvtpk_b(P[B_+0], P[B_+1]), a1 = cvtpk_b(P[B_+2], P[B_+3]);                          \
        unsigned b0 = cvtpk_b(P[B_+4], P[B_+5]), b1 = cvtpk_b(P[B_+6], P[B_+7]);                                             \
        auto r0 = __builtin_amdgcn_permlane32_swap(a0, b0, false, false); auto r1 = __builtin_amdgcn_permlane32_swap(a1, b1, false, false); \
        u32x4 w = {r0[0], r1[0], r0[1], r1[1]}; OUT = *reinterpret_cast<bf16x8*>(&w); } while (0)
    PK4(p0, 0, pa0); PK4(p0, 8, pa1); PK4(p1, 0, pa2); PK4(p1, 8, pa3);
#undef PK4
}
template <int KB, bool PRIO = true>
__device__ __forceinline__ void qkt(f32x16& p0, f32x16& p1, const char* K_lds, int r32, int hi, const bf16x8* qr) {
    p0 = f32x16{}; p1 = f32x16{}; if (PRIO) ATT_PRIO(1);
#pragma unroll
    for (int d0 = 0; d0 < 4; ++d0) { const char* a = K_lds + KB * SHM_K + KSWZ(r32, (d0 * 16 + hi * 8) * 2);
        bf16x8 b0 = *reinterpret_cast<const bf16x8*>(a);
        bf16x8 b1 = *reinterpret_cast<const bf16x8*>(a + 32 * 256);
        p0 = __builtin_amdgcn_mfma_f32_32x32x16_bf16(b0, qr[d0], p0, 0, 0, 0);
        p1 = __builtin_amdgcn_mfma_f32_32x32x16_bf16(b1, qr[d0], p1, 0, 0, 0); }
    if (PRIO) ATT_PRIO(0);
}
template <int VB>
__device__ __forceinline__ void pv_tile(f32x16* o, int vb0, bf16x8 pa0, bf16x8 pa1, bf16x8 pa2, bf16x8 pa3) {
#define TRRD(dst, off) asm volatile("ds_read_b64_tr_b16 %0, %1 offset:%2" : "=&v"(dst) : "v"(vb0), "i"(off) : "memory")
#define PV_D0(d0) do { s16x4 l0, l1, l2, l3, h0, h1, h2, h3; constexpr int b_ = VB * SHM_V + v_rd_off(d0, 0, 0); \
        TRRD(l0, b_); TRRD(h0, b_ + 2048); TRRD(l1, b_ + 4096); TRRD(h1, b_ + 6144); TRRD(l2, b_ + 8192); TRRD(h2, b_ + 10240); TRRD(l3, b_ + 12288); TRRD(h3, b_ + 14336); \
        asm volatile("s_waitcnt lgkmcnt(0)" ::: "memory"); SBAR();   \
        o[d0] = __builtin_amdgcn_mfma_f32_32x32x16_bf16(pa0, (bf16x8){l0[0], l0[1], l0[2], l0[3], h0[0], h0[1], h0[2], h0[3]}, o[d0], 0, 0, 0);   \
        o[d0] = __builtin_amdgcn_mfma_f32_32x32x16_bf16(pa1, (bf16x8){l1[0], l1[1], l1[2], l1[3], h1[0], h1[1], h1[2], h1[3]}, o[d0], 0, 0, 0);   \
        o[d0] = __builtin_amdgcn_mfma_f32_32x32x16_bf16(pa2, (bf16x8){l2[0], l2[1], l2[2], l2[3], h2[0], h2[1], h2[2], h2[3]}, o[d0], 0, 0, 0);   \
        o[d0] = __builtin_amdgcn_mfma_f32_32x32x16_bf16(pa3, (bf16x8){l3[0], l3[1], l3[2], l3[3], h3[0], h3[1], h3[2], h3[3]}, o[d0], 0, 0, 0); } while (0)
    ATT_PRIO(1); PV_D0(0); PV_D0(1); PV_D0(2); PV_D0(3);
#undef PV_D0
#undef TRRD
    const bf16x8 ones = {16256, 16256, 16256, 16256, 16256, 16256, 16256, 16256};
    o[4] = __builtin_amdgcn_mfma_f32_32x32x16_bf16(pa0, ones, o[4], 0, 0, 0); o[4] = __builtin_amdgcn_mfma_f32_32x32x16_bf16(pa1, ones, o[4], 0, 0, 0);
    o[4] = __builtin_amdgcn_mfma_f32_32x32x16_bf16(pa2, ones, o[4], 0, 0, 0); o[4] = __builtin_amdgcn_mfma_f32_32x32x16_bf16(pa3, ones, o[4], 0, 0, 0); ATT_PRIO(0);
}
__device__ __forceinline__ void partialSM_bf(f32x16& p0, f32x16& p1, float& m_reg, float& alpha) {
    float pmax = p0[0]; for (int r = 1; r < 16; ++r) pmax = fmaxf(pmax, p0[r]); for (int r = 0; r < 16; ++r) pmax = fmaxf(pmax, p1[r]);
    { auto rr = __builtin_amdgcn_permlane32_swap(__float_as_uint(pmax), __float_as_uint(pmax), false, false);
      pmax = fmaxf(__uint_as_float(rr[0]), __uint_as_float(rr[1])); }
    const float mn = (pmax - m_reg > THR) ? pmax : m_reg;
    alpha = __builtin_amdgcn_exp2f(m_reg - mn); m_reg = mn;
    for (int r = 0; r < 16; ++r) p0[r] = p0[r] - mn; for (int r = 0; r < 16; ++r) p1[r] = p1[r] - mn;
    for (int r = 0; r < 16; ++r) p0[r] = __builtin_amdgcn_exp2f(p0[r]);
}
typedef __attribute__((address_space(3))) char lchar;
__device__ __forceinline__ s16x4 vtrb(const lchar* p) { typedef short v4i16_t __attribute__((ext_vector_type(4))); typedef __attribute__((address_space(3))) v4i16_t* lp_t; return __builtin_bit_cast(s16x4, __builtin_amdgcn_ds_read_tr16_b64_v4i16((lp_t)p)); }
template <int VB>
__device__ __forceinline__ void pv_tile_b(f32x16* o, const lchar* vl, bf16x8 pa0, bf16x8 pa1, bf16x8 pa2, bf16x8 pa3) {
#pragma unroll
    for (int d0 = 0; d0 < 4; ++d0) { const lchar* b = vl + VB * SHM_V + v_rd_off(d0, 0, 0);
        const s16x4 l0 = vtrb(b), h0 = vtrb(b + 2048), l1 = vtrb(b + 4096), h1 = vtrb(b + 6144), l2 = vtrb(b + 8192), h2 = vtrb(b + 10240), l3 = vtrb(b + 12288), h3 = vtrb(b + 14336);
        o[d0] = __builtin_amdgcn_mfma_f32_32x32x16_bf16(pa0, (bf16x8){l0[0], l0[1], l0[2], l0[3], h0[0], h0[1], h0[2], h0[3]}, o[d0], 0, 0, 0);
        o[d0] = __builtin_amdgcn_mfma_f32_32x32x16_bf16(pa1, (bf16x8){l1[0], l1[1], l1[2], l1[3], h1[0], h1[1], h1[2], h1[3]}, o[d0], 0, 0, 0);
        o[d0] = __builtin_amdgcn_mfma_f32_32x32x16_bf16(pa2, (bf16x8){l2[0], l2[1], l2[2], l2[3], h2[0], h2[1], h2[2], h2[3]}, o[d0], 0, 0, 0);
        o[d0] = __builtin_amdgcn_mfma_f32_32x32x16_bf16(pa3, (bf16x8){l3[0], l3[1], l3[2], l3[3], h3[0], h3[1], h3[2], h3[3]}, o[d0], 0, 0, 0); }
    const bf16x8 ones = {16256, 16256, 16256, 16256, 16256, 16256, 16256, 16256};
    o[4] = __builtin_amdgcn_mfma_f32_32x32x16_bf16(pa0, ones, o[4], 0, 0, 0); o[4] = __builtin_amdgcn_mfma_f32_32x32x16_bf16(pa1, ones, o[4], 0, 0, 0);
    o[4] = __builtin_amdgcn_mfma_f32_32x32x16_bf16(pa2, ones, o[4], 0, 0, 0); o[4] = __builtin_amdgcn_mfma_f32_32x32x16_bf16(pa3, ones, o[4], 0, 0, 0);
}
struct BlockRef { const bf16* Q; const bf16* K; const bf16* V; bf16* O; int P0; };
struct Seam { bf16x8 qr[4]; bf16x8 st_v0, st_v1, st_k0; };
#define VMW() asm volatile("s_waitcnt vmcnt(0)" ::: "memory")
#define VMWN(n) asm volatile("s_waitcnt vmcnt(%0)" :: "i"(n) : "memory")
#define SLOAD_H(Kp, Vp, k0) do { S.st_v0 = load8((Vp) + (size_t)((k0) + sr) * VS + sc); S.st_v1 = load8((Vp) + (size_t)((k0) + 32 + sr) * VS + sc); \
                                 S.st_k0 = load8((Kp) + (size_t)((k0) + kr) * KS + kc); } while (0)
#define SWRITE_HK(bf) do { *(bf16x8*)(K_lds + (bf) * SHM_K + kws) = S.st_k0; } while (0)
#define SWRITE_HV(bf) do { *(bf16x8*)(V_lds + (bf) * SHM_V + vst0) = S.st_v0; *(bf16x8*)(V_lds + (bf) * SHM_V + vst1) = S.st_v1; } while (0)
#define SWRITE_H(bf) do { SWRITE_HV(bf); SWRITE_HK(bf); } while (0)
__device__ __forceinline__ void causal_prime(const BlockRef& cur, char* lds, Seam& S) {
    int tid = threadIdx.x; asm volatile("" : "+v"(tid));
    const int wid = __builtin_amdgcn_readfirstlane(tid >> 6), lane = tid & 63, r32 = lane & 31, hi = lane >> 5;
    const int sr = tid >> 4, sc = (tid & 15) * 8, kr = tid >> 3, kc = (tid & 7) * 8, kws = KSWZ(kr, kc * 2); char* K_lds = lds + 2 * SHM_V;
    for (int d0 = 0; d0 < 4; ++d0) S.qr[d0] = load8(cur.Q + (size_t)(wid * QBLK + r32) * QS + d0 * 16 + hi * 8);
    SLOAD_H(cur.K, cur.V, 0); VMW(); SWRITE_HK(0);
    __syncthreads();
}
__device__ __forceinline__ void causal_block(const BlockRef& cur, const BlockRef& nxt, char* lds, Seam& S) {
    int tid = threadIdx.x; asm volatile("" : "+v"(tid));
    const int wid = __builtin_amdgcn_readfirstlane(tid >> 6), lane = tid & 63, r32 = lane & 31, hi = lane >> 5;
    const int NT = (cur.P0 + QB) / KVBLK;
    const int qlo = cur.P0 + wid * QBLK, qm = qlo + r32 - 4 * hi;
    char* V_lds = lds; char* K_lds = lds + 2 * SHM_V;
    float* ws = (float*)(lds + 2 * SHM_V + 2 * SHM_K) + wid * 64; float* li_l = ws, * al_l = ws + 32;
    float m_reg = -1e30f; f32x16 o[5] = {};
    const int sr = tid >> 4, sc = (tid & 15) * 8, vst0 = v_st(sr, sc), vst1 = v_st(32 + sr, sc), kr = tid >> 3, kc = (tid & 7) * 8, kws = KSWZ(kr, kc * 2);
    const int vb0 = (int)(uintptr_t)V_lds + v_rd_base(lane);
    const lchar* vl = (const lchar*)(size_t)(unsigned)vb0;
    const bf16* Kh = cur.K; const bf16* Vh = cur.V;
#define RESC(a) do { if (__any((a) < 1.f)) { if (hi == 0) al_l[r32] = (a); asm volatile("s_waitcnt lgkmcnt(0)" ::: "memory");              \
                     for (int d_ = 0; d_ < 5; ++d_) for (int r = 0; r < 16; ++r) o[d_][r] *= al_l[crow(r, hi)]; } } while (0)
#define KBASE(t) ((t) * KVBLK)
#define MASKT(P0_, P1_, t) do { const int kb_ = KBASE(t); if (kb_ + KVBLK - 1 > qlo) mask_tile(P0_, P1_, qm - kb_); } while (0)
#define SEAM_K0() do { VMWN(4); SWRITE_HK(0); SBAR(); } while (0)
    f32x16 pA0, pA1, pB0, pB1; float mnA, mnB, alA, alB; bf16x8 pa0, pa1, pa2, pa3;
    SWRITE_HV(0); SBAR();
    SLOAD_H(Kh, Vh, KBASE(1));
    SBAR(); qkt<0>(pA0, pA1, K_lds, r32, hi, S.qr);
    MASKT(pA0, pA1, 0); partialSM(pA0, pA1, m_reg, mnA, alA);
    VMW(); SWRITE_H(1);
    __syncthreads();
#define SGB(mask, n) __builtin_amdgcn_sched_group_barrier(mask, n, 0)
#define R1_PIPE() do { SGB(0x100, 4); _Pragma("unroll") for (int i_ = 0; i_ < 4; ++i_) { SGB(0x008, 1); SGB(0x402, 5); SGB(0x100, 1); } _Pragma("unroll") for (int i_ = 0; i_ < 4; ++i_) { SGB(0x008, 1); SGB(0x402, 5); } } while (0)
#define R2_PIPE() do { SGB(0x100, 8); _Pragma("unroll") for (int i_ = 0; i_ < 12; ++i_) { SGB(0x008, 1); SGB(0x402, 4); SGB(0x100, 2); } _Pragma("unroll") for (int i_ = 0; i_ < 8; ++i_) { SGB(0x008, 1); SGB(0x402, 4); } } while (0)
#define PIN2(P0_, P1_) asm volatile("" : "+v"(P0_), "+v"(P1_))
#define HALF_STEP(PX0, PX1, mnX, alX, PY0, PY1, alY, t, KB, VB, SB) do {                                                      \
        SBAR(); qkt<KB, false>(PX0, PX1, K_lds, r32, hi, S.qr);                                                               \
        finishSM(PY0, PY1, pa0, pa1, pa2, pa3); R1_PIPE(); SBAR();                                                            \
        if ((t) + 1 < NT) { SLOAD_H(Kh, Vh, KBASE((t) + 1)); SBAR(); }                                                        \
        MASKT(PX0, PX1, (t)); SBAR();                                                                                         \
        pv_tile_b<VB>(o, vl, pa0, pa1, pa2, pa3); partialSM_bf(PX0, PX1, m_reg, alX); R2_PIPE(); PIN2(PX0, PX1); SBAR();      \
        __syncthreads();                                                                                                      \
        if ((t) + 1 < NT) { VMW(); SWRITE_H(SB); }                                                                            \
        RESC(alX); __syncthreads(); } while (0)
    for (int t = 1; t + 1 < NT; t += 2) {
        HALF_STEP(pB0, pB1, mnB, alB, pA0, pA1, alA, t, 1, 0, 0);
        HALF_STEP(pA0, pA1, mnA, alA, pB0, pB1, alB, t + 1, 0, 1, 1);
    }
    SBAR(); qkt<1>(pB0, pB1, K_lds, r32, hi, S.qr); SBAR();
    SLOAD_H(nxt.K, nxt.V, 0); SBAR();
#pragma unroll
    for (int d0 = 0; d0 < 4; ++d0) S.qr[d0] = load8(nxt.Q + (size_t)(wid * QBLK + r32) * QS + d0 * 16 + hi * 8);
    SBAR();
    finishSM(pA0, pA1, pa0, pa1, pa2, pa3); SBAR();
    pv_tile<0>(o, vb0, pa0, pa1, pa2, pa3);
    MASKT(pB0, pB1, NT - 1); partialSM(pB0, pB1, m_reg, mnB, alB); __syncthreads(); RESC(alB);
    finishSM(pB0, pB1, pa0, pa1, pa2, pa3); SBAR(); pv_tile<1>(o, vb0, pa0, pa1, pa2, pa3);
    SBAR(); SEAM_K0();
    float rli[16];
#pragma unroll
    for (int r = 0; r < 16; ++r) rli[r] = __builtin_amdgcn_rcpf(o[4][r]);
    bf16* Ow = cur.O + (size_t)(wid * QBLK) * OS;
#pragma unroll
    for (int r = 0; r < 16; ++r) { const int orow = crow(r, hi);
#pragma unroll
        for (int d0 = 0; d0 < 4; ++d0) { const float v = o[d0][r] * rli[r]; const float vn = __shfl_xor(v, 1);
            if ((r32 & 1) == 0) *(unsigned*)(Ow + (size_t)orow * OS + d0 * 32 + r32) = cvtpk(v, vn); } }
    __syncthreads();
#undef RESC
#undef KBASE
#undef MASKT
#undef SEAM_K0
#undef HALF_STEP
#undef R2_PIPE
#undef PIN2
#undef R1_PIPE
#undef SGB
}
#undef VMW
#undef VMWN
#undef SLOAD_H
#undef SWRITE_HK
#undef SWRITE_HV
#undef SWRITE_H
__device__ __forceinline__ BlockRef make_ref(const bf16* P, bf16* OC, int p, int pass) {
    const int s = p & 7, bhc = p >> 3, b = bhc >> 4, hc = bhc & 15, qb = pass ? 15 - s : s; BlockRef r;
    const size_t row0 = (size_t)b * ::SEQ;
    r.Q = P + (row0 + (size_t)qb * QB) * QS + ::C_QA + hc * 64; r.K = P + row0 * KS + ::C_KA + hc * 64; r.V = P + row0 * VS + ::C_VA + (hc >> 1) * 128;
    r.O = OC + (row0 + (size_t)qb * QB) * OS + hc * 128; r.P0 = qb * QB; return r;
}
__device__ __forceinline__ void attn_phase(char* lds, const bf16* P, bf16* OC, int vcu, int G) {
    int p = vcu; if (p >= 256) return; int pass = 0;
    BlockRef cur = make_ref(P, OC, p, 0); Seam S;
    causal_prime(cur, lds, S);
    for (;;) {
        const bool more_pass = pass == 0, more_item = p + G < 256, last = !more_pass && !more_item;
        int pn = p, passn = pass + 1; if (!more_pass) { passn = 0; pn = more_item ? p + G : p; }
        const BlockRef nxt = last ? cur : make_ref(P, OC, pn, passn);
        causal_block(cur, nxt, lds, S);
        if (last) break;
        cur = nxt; p = pn; pass = passn;
    }
}
#undef KSWZ
#undef SBAR
}
constexpr int NWAVES = 8;
#ifndef MK_SPLIT
#define MK_SPLIT 0
#endif
constexpr int N_PHASES = 3 + 6 * DEPTH;

constexpr size_t MiB = 1u << 20;
constexpr size_t WS_CTL = 0, CTL_ZERO_BYTES = 1 * MiB;
constexpr size_t WS_SS = 512 * 1024;
constexpr size_t WS_COSA = 1 * MiB, WS_SINA = WS_COSA + 512 * 1024;
constexpr size_t WS_COSB = 2 * MiB, WS_SINB = 3 * MiB;
constexpr size_t WS_LSE = 4 * MiB;
constexpr size_t WS_PWT = 6 * MiB;
constexpr size_t WS_WUNT = 8 * MiB;
constexpr size_t WS_W = 32 * MiB;
constexpr size_t W_IN = 0, W_OUT = 80 * MiB, W_UP = 112 * MiB, W_DN = 240 * MiB, W_LAYER = 368 * MiB;
constexpr size_t WS_HN = WS_W + DEPTH * W_LAYER;
constexpr size_t WS_PROJ = WS_HN + 66 * MiB;
constexpr size_t WS_MIX = WS_PROJ + 162 * MiB;
constexpr size_t WS_OC = WS_MIX + 66 * MiB;
constexpr size_t WS_ACT = WS_OC + 34 * MiB;
constexpr size_t WS_END = WS_ACT + 258 * MiB;
static_assert(WS_HN == 768 * MiB && (size_t)M * LDH * 2 <= 66 * MiB && (size_t)M * LDP * 2 <= 162 * MiB && (size_t)M * LDOC * 2 <= 34 * MiB && (size_t)M * LDACT * 2 <= 258 * MiB && WS_END <= 1400 * MiB, "d_ws map");
constexpr int CW_RANK = 8192;
constexpr int CW_BAR = 4096;

constexpr int RING_OFF = 0, RING_BYTES = 131072;
constexpr int LDSCTL_OFF = RING_BYTES, MISC_OFF = LDSCTL_OFF + 320;
constexpr int LDS_BYTES = 147456;
static_assert(MISC_OFF + 128 <= LDS_BYTES && attn128::LDS_BYTES <= RING_BYTES, "LDS map");

#define LAS __attribute__((address_space(3)))
typedef unsigned short bf16;
typedef unsigned v4u __attribute__((ext_vector_type(4)));
typedef unsigned v2u __attribute__((ext_vector_type(2)));
typedef float f32x4 __attribute__((ext_vector_type(4)));
typedef float f32x16 __attribute__((ext_vector_type(16)));
typedef short bf16x8 __attribute__((ext_vector_type(8)));
typedef short s16x4 __attribute__((ext_vector_type(4)));
using pg8::cvt_pk_bf16;
__device__ __forceinline__ float bf_lo(unsigned u) { return __uint_as_float(u << 16); }
__device__ __forceinline__ float bf_hi(unsigned u) { return __uint_as_float(u & 0xffff0000u); }

#define XB_TMO      128
#define XB_XCNT(j)  (256  + 64 * (j))
#define XB_XSUB(j)  (1280 + 64 * (j))
#define XB_XGEN(j)  (2304 + 64 * (j))
#define XB_TOP      3328
#define XB_TOPGEN   3392
#define XCD_BAR_WORDS 3456
#define XB_SPIN_CAP (1u << 18)

__device__ __forceinline__ unsigned xb_ld(unsigned* p)              { return __hip_atomic_load(p, __ATOMIC_RELAXED, __HIP_MEMORY_SCOPE_AGENT); }
__device__ __forceinline__ unsigned xb_add(unsigned* p, unsigned v) { return __hip_atomic_fetch_add(p, v, __ATOMIC_RELAXED, __HIP_MEMORY_SCOPE_AGENT); }
__device__ __forceinline__ unsigned xb_xcc_id() { return (unsigned)__builtin_amdgcn_s_getreg((3 << 11) | 20) & 0xFu; }
#define XB_SPIN(cond, bar) do { unsigned _sp = 0; while (cond) { __builtin_amdgcn_s_sleep(1); \
    if ((++_sp & 255u) == 0u) { if (xb_ld(&(bar)[XB_TMO])) break; if (_sp > XB_SPIN_CAP) { atomicAdd(&(bar)[XB_TMO], 1u); break; } } } } while (0)

struct XcdBarrier {
    unsigned* bar; unsigned x;
    volatile LAS unsigned* st;
};
__device__ __forceinline__ XcdBarrier xcd_barrier_post(unsigned* bar, volatile LAS unsigned* st) {
    XcdBarrier b; b.bar = bar; b.x = xb_xcc_id(); b.st = st;
    if (threadIdx.x == 0) (void)xb_add(&bar[XB_XCNT(b.x)], 1u);
    return b;
}
__device__ __forceinline__ void xcd_barrier_complete(unsigned* bar, unsigned x, unsigned& nloc, unsigned& nx) {
    const unsigned G = gridDim.x * gridDim.y * gridDim.z;
    unsigned sum, cnt, mine, sp = 0u;
    for (;;) {
        sum = 0u; cnt = 0u; mine = 0u;
#pragma unroll
        for (unsigned j = 0; j < 16; ++j) { const unsigned c = xb_ld(&bar[XB_XCNT(j)]); sum += c; cnt += (c > 0u) ? 1u : 0u; mine = (j == x) ? c : mine; }
        if (sum == G) break;
        __builtin_amdgcn_s_sleep(1);
        if ((++sp & 255u) == 0u) { if (xb_ld(&bar[XB_TMO])) break; if (sp > XB_SPIN_CAP) { atomicAdd(&bar[XB_TMO], 1u); break; } }
    }
    nloc = mine > 0u ? mine : 1u; nx = cnt > 0u ? cnt : 1u;
}
__device__ __forceinline__ void xcd_barrier(const XcdBarrier& b) {
    asm volatile("s_waitcnt vmcnt(0)" ::: "memory");
    __syncthreads();
    if (threadIdx.x == 0) {
        unsigned* bar = b.bar;
        __builtin_amdgcn_s_waitcnt(0);
        unsigned nloc = b.st[0], nx = b.st[1];
        if (nloc == 0u) { xcd_barrier_complete(bar, b.x, nloc, nx); b.st[0] = nloc; b.st[1] = nx; }
        const unsigned old = xb_add(&bar[XB_XSUB(b.x)], 1u);
        const unsigned gen = old / nloc;
        if (old + 1u == (gen + 1u) * nloc) {
            __builtin_amdgcn_fence(__ATOMIC_RELEASE, "agent");
            asm volatile("s_waitcnt vmcnt(0)" ::: "memory");
            const unsigned og = xb_add(&bar[XB_TOP], 1u);
            const unsigned tg = og / nx;
            if (og + 1u == (tg + 1u) * nx) xb_add(&bar[XB_TOPGEN], 1u);
            else XB_SPIN(xb_ld(&bar[XB_TOPGEN]) == tg, bar);
            __builtin_amdgcn_fence(__ATOMIC_ACQUIRE, "agent");
            xb_add(&bar[XB_XGEN(b.x)], 1u);
            asm volatile("s_waitcnt vmcnt(0)" ::: "memory");
        } else {
            XB_SPIN(xb_ld(&bar[XB_XGEN(b.x)]) == gen, bar);
            __builtin_amdgcn_fence(__ATOMIC_ACQUIRE, "agent");
            asm volatile("s_waitcnt vmcnt(0)" ::: "memory");
        }
    }
    __syncthreads();
}

struct Args { const float* in[13]; float* out; unsigned char* ws; int ph_lo, ph_hi; };
__device__ __forceinline__ float wave_sum(float v) {
#pragma unroll
    for (int o = 1; o < 64; o <<= 1) v += __shfl_xor(v, o);
    return v;
}
__device__ __forceinline__ int nperm(int n) {
    const int tile = n >> 8, c = n & 255; int cp = c;
    if (tile < 8) { const int q = c >> 6, i = c & 63; cp = (i < 32) ? 32 * q + i : 128 + 32 * q + (i - 32); }
    else if (tile >= 12 && tile <= 20) { const int u = c >> 7, i = c & 127; cp = (i < 64) ? 64 * u + i : 128 + 64 * u + (i - 64); }
    return tile * 256 + cp;
}
template <int MODE, int K, int N>
__device__ __forceinline__ void conv_blocked(const float* __restrict__ W, bf16* D, const float* __restrict__ gk, unsigned gtid, unsigned nthr, LAS unsigned char* scr  ) {
    constexpr unsigned items = (unsigned)(K >> 5) * (unsigned)N;
    const int lane = (int)(gtid & 63u);
    for (unsigned it = gtid; it < items; it += nthr) {
        const unsigned kb = it / (unsigned)N; const int n = (int)(it - kb * (unsigned)N), k0 = (int)kb * 32;
        if (MODE == 1 && n >= C_U && n < C_GB) continue;
        const float* src = W + (size_t)k0 * N + n;
        float v[32];
#pragma unroll
        for (int i = 0; i < 32; ++i) v[i] = __builtin_nontemporal_load(src + (size_t)i * N);
        if (gk) {
#pragma unroll
            for (int i = 0; i < 32; ++i) v[i] *= gk[k0 + i];
        }
        const int rho = pg8::p32inv(lane & 31), half = lane >> 5;
#pragma unroll
        for (int c = 0; c < 4; ++c) { v4u o; o.x = cvt_pk_bf16(v[8 * c], v[8 * c + 1]); o.y = cvt_pk_bf16(v[8 * c + 2], v[8 * c + 3]); o.z = cvt_pk_bf16(v[8 * c + 4], v[8 * c + 5]); o.w = cvt_pk_bf16(v[8 * c + 6], v[8 * c + 7]);
            *(LAS v4u*)(scr + (half * 32 + rho) * 64 + ((c * 16) ^ ((rho & 8) << 2))) = o; }
        const int nb = n - lane;
#pragma unroll
        for (int i = 0; i < 4; ++i) { const int h2 = i >> 1, b2 = i & 1; const int gp = ((MODE == 1) ? nperm(nb + 32 * h2) : nb + 32 * h2) & ~31;
            const v4u o = *(const LAS v4u*)(scr + (h2 * 32 + b2 * 16) * 64 + lane * 16);
            *(v4u*)((unsigned char*)D + ((size_t)((gp >> 4) + b2) * (K >> 5) + (size_t)(k0 >> 5)) * 1024 + lane * 16) = o; }
        asm volatile("s_waitcnt lgkmcnt(0)" ::: "memory");
    }
}
__device__ __forceinline__ void xb_rows(const float* X, bf16* H, pg8::ss_t* ss, int gw, int ngw, int lane) {
    asm volatile("" : "+v"(lane));
    for (int m = gw; m < M; m += ngw) {
        const f32x4* xr = (const f32x4*)(X + (size_t)m * DM) + lane;
        f32x4 v[16]; float s = 0.f;
#pragma unroll
        for (int j = 0; j < 16; ++j) { v[j] = xr[64 * j]; s += (v[j].x * v[j].x + v[j].y * v[j].y) + (v[j].z * v[j].z + v[j].w * v[j].w); }
        s = wave_sum(s); if (lane == 0) ss[m] = (pg8::ss_t)(s * pg8::SS_SCALE);
#pragma unroll
        for (int j = 0; j < 16; ++j) { v2u o; o.x = cvt_pk_bf16(v[j].x, v[j].y); o.y = cvt_pk_bf16(v[j].z, v[j].w); *(v2u*)(H + pg8::img_elem(m, 4 * (lane + 64 * j), DM)) = o; }
    }
}
__device__ __forceinline__ void rmsnorm_final(const bf16* XB, const pg8::ss_t* __restrict__ ss, float* out, const float* __restrict__ g, int gw, int ngw, int lane) {
    asm volatile("" : "+v"(lane));
    for (int m = gw; m < M; m += ngw) {
        const float rstd = 1.f / sqrtf((float)ss[m] * (pg8::SS_INV / DM) + 1e-6f); f32x4* orow = (f32x4*)(out + (size_t)m * DM) + lane; const f32x4* gr = (const f32x4*)g + lane;
#pragma unroll
        for (int j = 0; j < 16; ++j) { const v2u w = *(const v2u*)(XB + pg8::img_elem(m, 4 * (lane + 64 * j), DM));
            const f32x4 x = {bf_lo(w.x), bf_hi(w.x), bf_lo(w.y), bf_hi(w.y)}; orow[64 * j] = x * rstd * gr[64 * j]; }
    }
}

__device__ __forceinline__ void p0_prologue(const __attribute__((address_space(4))) Args* ka, unsigned char* ws, unsigned gtid, unsigned nthr, int gw, int ngw, int lane, LAS unsigned char* scr) {
    const float* in[13];
#pragma unroll
    for (int i = 0; i < 13; ++i) in[i] = ka->in[i];
    { float* cosA = (float*)(ws + WS_COSA); float* sinA = (float*)(ws + WS_SINA); float* cosB = (float*)(ws + WS_COSB); float* sinB = (float*)(ws + WS_SINB);
      for (unsigned it = gtid; it < (unsigned)SEQ * 96u; it += nthr) { const unsigned pos = it / 96u, j = it - pos * 96u; const bool isA = j < 32u; const int i = isA ? (int)j : (int)j - 32;
          const double inv = exp2(-(double)i * (isA ? (1.0 / 32.0) : (1.0 / 64.0)) * 13.287712379549449);
          double rev = (double)pos * inv * 0.15915494309189535; rev -= rint(rev);
          const float rv = (float)rev, c = __builtin_amdgcn_cosf(rv), s = __builtin_amdgcn_sinf(rv);
          if (isA) { cosA[pos * 32 + i] = c; sinA[pos * 32 + i] = s; } else { cosB[pos * 64 + i] = c; sinB[pos * 64 + i] = s; } } }
    { const float* pw = in[7]; const float* ps = in[8]; bf16* PWT = (bf16*)(ws + WS_PWT);
      for (unsigned it = gtid; it < (unsigned)DEPTH * 4u * 256u * 32u; it += nthr) { const unsigned c8 = it & 31u, d = (it >> 5) & 255u, lg = it >> 13;
          const float sc = ps[lg * 256u + d]; const float* src = pw + ((size_t)lg * 256 + c8 * 8) * 256 + d; float v[8];
#pragma unroll
          for (int i = 0; i < 8; ++i) v[i] = src[(size_t)i * 256] * sc;
          v4u o; o.x = cvt_pk_bf16(v[0], v[1]); o.y = cvt_pk_bf16(v[2], v[3]); o.z = cvt_pk_bf16(v[4], v[5]); o.w = cvt_pk_bf16(v[6], v[7]);
          *(v4u*)(PWT + pg8::img_elem((int)(lg * 256u + d), (int)c8 * 8, 256)) = o; } }
    { for (unsigned it = gtid; it < (unsigned)DEPTH * 4096u * 128u; it += nthr) { const unsigned cc = it & 127u, k = (it >> 7) & 4095u, l = it >> 19, g = cc >> 5, c8 = cc & 31u;
          const float* src = in[1] + ((size_t)l * DM + k) * NIN + C_U + cc * 8; const float gm = in[3][l * DM + k];
          const f32x4 a = *(const f32x4*)src * gm, b = *(const f32x4*)(src + 4) * gm;
          v4u o; o.x = cvt_pk_bf16(a[0], a[1]); o.y = cvt_pk_bf16(a[2], a[3]); o.z = cvt_pk_bf16(b[0], b[1]); o.w = cvt_pk_bf16(b[2], b[3]);
          *(v4u*)((bf16*)(ws + WS_WUNT) + (size_t)(l * 4 + g) * (4096 * 256) + pg8::img_elem(pg8::brow((int)k), (int)c8 * 8, 256)) = o; } }
#ifndef PROBE_P0
#define PROBE_P0 1
#endif
    for (int l2 = 0; l2 < DEPTH * PROBE_P0; ++l2) { const int l = DEPTH - 1 - (l2 % DEPTH);
        unsigned char* wl = ws + WS_W + (size_t)l * W_LAYER;
        conv_blocked<0, DFF, DM>(in[11] + (size_t)l * DFF * DM, (bf16*)(wl + W_DN), nullptr, gtid, nthr, scr);
        conv_blocked<0, DM, DFF>(in[10] + (size_t)l * DM * DFF, (bf16*)(wl + W_UP), in[4] + l * DM, gtid, nthr, scr);
        conv_blocked<0, DM, DM>(in[2] + (size_t)l * DM * DM, (bf16*)(wl + W_OUT), nullptr, gtid, nthr, scr);
        conv_blocked<1, DM, NIN>(in[1] + (size_t)l * DM * NIN, (bf16*)(wl + W_IN), in[3] + l * DM, gtid, nthr, scr);
    }
    xb_rows(in[0], (bf16*)(ws + WS_HN), (pg8::ss_t*)(ws + WS_SS), gw, ngw, lane);
}

__device__ __forceinline__ s16x4 vtr(const LAS char* p) { typedef short v4i16_t __attribute__((ext_vector_type(4))); return __builtin_bit_cast(s16x4, __builtin_amdgcn_ds_read_tr16_b64_v4i16((LAS v4i16_t*)p)); }
__device__ __forceinline__ int crow(int r, int hi) { return (r & 3) + 8 * (r >> 2) + 4 * hi; }
__device__ __forceinline__ void dil_tile(const bf16* __restrict__ P, bf16* MIX, float* LSE, int T, LAS char* vimg, int lane) {
    asm volatile("" : "+v"(lane));
    const int r32 = lane & 31, hi = lane >> 5;
    const int bh = T >> 7, within = T & 127, b = bh / 9, head = bh - 9 * b, gi = head / 3, dsh = 2 * gi;
    const int L32 = 128 >> dsh, r = within >> (7 - dsh), i0 = (within & (L32 - 1)) << 5, j0 = i0 - 128;
    const size_t row0 = (size_t)b * SEQ + r;
    bf16x8 qf[8];
    { const bf16* qp = P + (row0 + ((size_t)(i0 + r32) << dsh)) * LDP + C_QB + head * 128 + 8 * hi;
#pragma unroll
      for (int s = 0; s < 8; ++s) qf[s] = *(const bf16x8*)(qp + 16 * s); }
    f32x16 S[5];
#pragma unroll
    for (int kt = 0; kt < 5; ++kt) {
        int ln = lane; asm volatile("" : "+v"(ln));
#pragma unroll
        for (int it = 0; it < 8; ++it) { const int rr = (ln >> 4) + 4 * it, c16 = ln & 15; const int key = j0 + 32 * kt + rr, kc = key < 0 ? 0 : key;
            __builtin_amdgcn_global_load_lds((const unsigned*)(P + (row0 + ((size_t)kc << dsh)) * LDP + C_KB + head * 128 + 8 * (c16 ^ (rr & 15))), (LAS unsigned*)(vimg + it * 1024), 16, 0, 0); }
        asm volatile("s_waitcnt vmcnt(0)" ::: "memory");
        bf16x8 kf[8];
#pragma unroll
        for (int s = 0; s < 8; ++s) kf[s] = *(const LAS bf16x8*)(vimg + r32 * 256 + (((2 * s + hi) ^ (r32 & 15)) << 4));
        asm volatile("s_waitcnt lgkmcnt(0)" ::: "memory");
        f32x16 a = {};
#pragma unroll
        for (int s = 0; s < 8; ++s) a = __builtin_amdgcn_mfma_f32_32x32x16_bf16(kf[s], qf[s], a, 0, 0, 0);
        S[kt] = a; }
    const int iq = i0 + r32; float mx = -INFINITY;
#pragma unroll
    for (int kt = 0; kt < 5; ++kt)
#pragma unroll
        for (int g = 0; g < 16; ++g) { const int key = j0 + 32 * kt + crow(g, hi); const bool ok = (key >= 0) && (key <= iq) && (key >= iq - 128); const float v = ok ? S[kt][g] : -INFINITY; S[kt][g] = v; mx = fmaxf(mx, v); }
    mx = fmaxf(mx, __shfl_xor(mx, 32));
    float l = 0.f;
#pragma unroll
    for (int kt = 0; kt < 5; ++kt)
#pragma unroll
        for (int g = 0; g < 16; ++g) { const float p = __builtin_amdgcn_exp2f(S[kt][g] - mx); S[kt][g] = p; l += p; }
    l += __shfl_xor(l, 32);
    if (hi == 0) LSE[(row0 + ((size_t)iq << dsh)) * 16 + head] = mx + __builtin_amdgcn_logf(l);
    const float rl = 1.f / l;
    f32x16 O[4] = {};
#pragma unroll
    for (int kt = 0; kt < 5; ++kt) {
#pragma unroll
        for (int it = 0; it < 8; ++it) { const int rr = (lane >> 4) + 4 * it, c16 = lane & 15; const int key = j0 + 32 * kt + rr, kc = key < 0 ? 0 : key;
            const v4u v = *(const v4u*)(P + (row0 + ((size_t)kc << dsh)) * LDP + C_VB + head * 128 + 8 * c16);
            *(LAS v4u*)(vimg + (c16 >> 2) * 2048 + rr * 64 + (c16 & 3) * 16) = v; }
        const LAS char* vb = vimg + ((lane >> 4) & 1) * 32 + (lane & 3) * 8 + (4 * hi + ((lane & 15) >> 2)) * 64;
#pragma unroll
        for (int s2 = 0; s2 < 2; ++s2) {
            v4u pw; pw.x = cvt_pk_bf16(S[kt][8 * s2 + 0] * rl, S[kt][8 * s2 + 1] * rl); pw.y = cvt_pk_bf16(S[kt][8 * s2 + 2] * rl, S[kt][8 * s2 + 3] * rl);
            pw.z = cvt_pk_bf16(S[kt][8 * s2 + 4] * rl, S[kt][8 * s2 + 5] * rl); pw.w = cvt_pk_bf16(S[kt][8 * s2 + 6] * rl, S[kt][8 * s2 + 7] * rl);
            const bf16x8 pa = __builtin_bit_cast(bf16x8, pw);
#pragma unroll
            for (int nb = 0; nb < 4; ++nb) { const s16x4 lo = vtr(vb + nb * 2048 + s2 * 1024), hh = vtr(vb + nb * 2048 + s2 * 1024 + 512);
                const bf16x8 vf = (bf16x8){lo[0], lo[1], lo[2], lo[3], hh[0], hh[1], hh[2], hh[3]};
                O[nb] = __builtin_amdgcn_mfma_f32_32x32x16_bf16(pa, vf, O[nb], 0, 0, 0); } }
    }
#pragma unroll
    for (int g = 0; g < 16; ++g) { const int orow = (int)(row0 + ((size_t)(i0 + crow(g, hi)) << dsh));
#pragma unroll
        for (int nb = 0; nb < 4; ++nb) MIX[pg8::img_elem(orow, MIX_B + head * 128 + 32 * nb + r32, DM)] = (bf16)(cvt_pk_bf16(O[nb][g], 0.f) & 0xffffu); }
}

__device__ __forceinline__ void unpack8(const v4u& w, float (&f)[8]) { f[0] = bf_lo(w.x); f[1] = bf_hi(w.x); f[2] = bf_lo(w.y); f[3] = bf_hi(w.y); f[4] = bf_lo(w.z); f[5] = bf_hi(w.z); f[6] = bf_lo(w.w); f[7] = bf_hi(w.w); }
__device__ __forceinline__ void mixer_cd(const bf16* __restrict__ P, bf16* MIX, const float* __restrict__ cw  , unsigned gtid, unsigned nthr) {
    asm volatile("" : "+v"(gtid));
    constexpr int RUN = 16;
    for (unsigned it = gtid; it < (unsigned)(M / RUN) * 256u; it += nthr) {
        const unsigned run = it >> 8, ch = it & 255u; if (ch >= 240u) continue; const int row0 = (int)run * RUN, t0 = row0 & (SEQ - 1);
        if (ch < 128u) {
            const int w = 2 << (ch >> 5); const bf16* p = P + (size_t)row0 * LDP + C_U + ch * 8; const int ocol = MIX_C + (int)ch * 8;
            float acc[8] = {0.f, 0.f, 0.f, 0.f, 0.f, 0.f, 0.f, 0.f};
            for (int i = 1; i < w; ++i) if (t0 - i >= 0) { float f[8]; unpack8(*(const v4u*)(p - (size_t)i * LDP), f);
#pragma unroll
                for (int e = 0; e < 8; ++e) acc[e] += f[e]; }
#pragma unroll 4
            for (int r = 0; r < RUN; ++r) { const int t = t0 + r; float cur[8]; unpack8(*(const v4u*)(p + (size_t)r * LDP), cur);
#pragma unroll
                for (int e = 0; e < 8; ++e) acc[e] += cur[e];
                const int cnt = (t + 1 < w) ? t + 1 : w; const float rc = 1.f / (float)cnt; v4u ov;
                ov.x = cvt_pk_bf16(acc[0] * rc - cur[0], acc[1] * rc - cur[1]); ov.y = cvt_pk_bf16(acc[2] * rc - cur[2], acc[3] * rc - cur[3]);
                ov.z = cvt_pk_bf16(acc[4] * rc - cur[4], acc[5] * rc - cur[5]); ov.w = cvt_pk_bf16(acc[6] * rc - cur[6], acc[7] * rc - cur[7]);
                *(v4u*)(MIX + pg8::img_elem(row0 + r, ocol, DM)) = ov;
                if (t - (w - 1) >= 0) { float f[8]; unpack8(*(const v4u*)(p + (size_t)(r - (w - 1)) * LDP), f);
#pragma unroll
                    for (int e = 0; e < 8; ++e) acc[e] -= f[e]; } }
        } else {
            const unsigned dc = ch - 128u; const bf16* pb = P + (size_t)row0 * LDP + C_GB + dc * 8; const bf16* pc = P + (size_t)row0 * LDP + C_GC + dc * 8; const bf16* ph = P + (size_t)row0 * LDP + C_HD + dc * 8;
            const int ocol = MIX_D + (int)dc * 8;
            float wk[3][8];
#pragma unroll
            for (int k = 0; k < 3; ++k) { const f32x4 a = *(const f32x4*)(cw + k * 896 + dc * 8), b = *(const f32x4*)(cw + k * 896 + dc * 8 + 4);
#pragma unroll
                for (int e = 0; e < 4; ++e) { wk[k][e] = a[e]; wk[k][4 + e] = b[e]; } }
            float z1[8], z2[8];
#pragma unroll
            for (int e = 0; e < 8; ++e) { z1[e] = 0.f; z2[e] = 0.f; }
            if (t0 >= 1) { float c[8], h[8]; unpack8(*(const v4u*)(pc - (size_t)LDP), c); unpack8(*(const v4u*)(ph - (size_t)LDP), h);
#pragma unroll
                for (int e = 0; e < 8; ++e) z1[e] = c[e] * h[e]; }
            if (t0 >= 2) { float c[8], h[8]; unpack8(*(const v4u*)(pc - (size_t)2 * LDP), c); unpack8(*(const v4u*)(ph - (size_t)2 * LDP), h);
#pragma unroll
                for (int e = 0; e < 8; ++e) z2[e] = c[e] * h[e]; }
#pragma unroll 4
            for (int r = 0; r < RUN; ++r) { float c[8], h[8], bb[8]; unpack8(*(const v4u*)(pc + (size_t)r * LDP), c); unpack8(*(const v4u*)(ph + (size_t)r * LDP), h); unpack8(*(const v4u*)(pb + (size_t)r * LDP), bb);
                float y[8];
#pragma unroll
                for (int e = 0; e < 8; ++e) { const float z0 = c[e] * h[e]; y[e] = bb[e] * (wk[0][e] * z2[e] + wk[1][e] * z1[e] + wk[2][e] * z0); z2[e] = z1[e]; z1[e] = z0; }
                v4u ov; ov.x = cvt_pk_bf16(y[0], y[1]); ov.y = cvt_pk_bf16(y[2], y[3]); ov.z = cvt_pk_bf16(y[4], y[5]); ov.w = cvt_pk_bf16(y[6], y[7]);
                *(v4u*)(MIX + pg8::img_elem(row0 + r, ocol, DM)) = ov; }
        }
    }
}

__device__ __forceinline__ void fix_rows(const bf16* __restrict__ OC, bf16* MIX, const float* __restrict__ LSE, const float* __restrict__ lamp  , const float* __restrict__ subln  ,
                                         float lam_init, int gw, int ngw, int lane) {
    asm volatile("" : "+v"(lane));
    const float lam = __expf(wave_sum(lamp[lane] * lamp[64 + lane])) - __expf(wave_sum(lamp[128 + lane] * lamp[192 + lane])) + lam_init;
    const float g0 = subln[2 * lane] * (1.f - lam_init), g1 = subln[2 * lane + 1] * (1.f - lam_init);
    for (int m = gw; m < M; m += ngw) {
        const unsigned* oc = (const unsigned*)(OC + (size_t)m * LDOC);
#pragma unroll
        for (int h = 0; h < 8; ++h) { const unsigned a = oc[h * 128 + lane], b = oc[h * 128 + 64 + lane];
            const float o0 = bf_lo(a) - lam * bf_lo(b), o1 = bf_hi(a) - lam * bf_hi(b);
            const float rn = 1.f / sqrtf(wave_sum(o0 * o0 + o1 * o1) * (1.f / 128.f) + 1e-5f);
            *(unsigned*)(MIX + pg8::img_elem(m, h * 128 + 2 * lane, DM)) = cvt_pk_bf16(o0 * rn * g0, o1 * rn * g1); }
        const float lv = LSE[(size_t)m * 16 + (lane < 9 ? lane : 0)];
#pragma unroll
        for (int hh = 0; hh < 3; ++hh) { const float l0 = __shfl(lv, hh), l1 = __shfl(lv, 3 + hh), l2 = __shfl(lv, 6 + hh), mm = fmaxf(l0, fmaxf(l1, l2));
            const float e0 = __builtin_amdgcn_exp2f(l0 - mm), e1 = __builtin_amdgcn_exp2f(l1 - mm), e2 = __builtin_amdgcn_exp2f(l2 - mm), inv = 1.f / (e0 + e1 + e2);
#pragma unroll
            for (int g = 0; g < 3; ++g) { const float al = (g == 0 ? e0 : (g == 1 ? e1 : e2)) * inv; unsigned* p = (unsigned*)(MIX + pg8::img_elem(m, MIX_B + (3 * g + hh) * 128 + 2 * lane, DM)); const unsigned v = *p; *p = cvt_pk_bf16(bf_lo(v) * al, bf_hi(v) * al); } }
    }
}

typedef const __attribute__((address_space(4))) Args* KArgs;
__device__ __forceinline__ KArgs kargs() { KArgs p = (KArgs)__builtin_amdgcn_kernarg_segment_ptr(); asm volatile("" : "+s"(p)); return p; }
#define ENV() \
    const KArgs ka = kargs(); unsigned char* const ws = ka->ws; \
    int tid = threadIdx.x; asm volatile("" : "+v"(tid)); \
    const int lane = tid & 63, wave = __builtin_amdgcn_readfirstlane(tid >> 6); \
    const int G = gridDim.x; volatile LAS unsigned* const MISCv = (volatile LAS unsigned*)(ldsp + MISC_OFF); \
    const int bx = MISCv[18] ? (int)(MISCv[17] * 8u + MISCv[16]) : (int)blockIdx.x;        \
    const int vcu = (G % 8 == 0) ? (bx % 8) * (G / 8) + bx / 8 : bx; \
    const unsigned gtid = (unsigned)vcu * 512u + (unsigned)tid, nthr = (unsigned)G * 512u; const int gw = vcu * NWAVES + wave, ngw = G * NWAVES; \
    (void)lane; (void)gtid; (void)nthr; (void)gw; (void)ngw; (void)bx; (void)ws
__global__ void __launch_bounds__(NWAVES * 64, 2) fwd(Args args_unused) {
    extern __shared__ __attribute__((aligned(16))) unsigned char lds[];
    LAS unsigned char* const ldsp = (LAS unsigned char*)lds;
    { const int tid0 = threadIdx.x; for (int u = tid0; u < (LDS_BYTES - LDSCTL_OFF) / 4; u += NWAVES * 64) ((LAS unsigned*)(ldsp + LDSCTL_OFF))[u] = 0u; }
    __syncthreads();
    int lo, hi; { const KArgs ka = kargs(); lo = ka->ph_lo; hi = ka->ph_hi; }
    if (threadIdx.x == 0) { unsigned* ctl0 = (unsigned*)(kargs()->ws + WS_CTL); const unsigned x = xb_xcc_id(); volatile LAS unsigned* Mv = (volatile LAS unsigned*)(ldsp + MISC_OFF);
        Mv[16] = x; Mv[17] = xb_add(&ctl0[CW_RANK + 64 * x], 1u); }
    __syncthreads();
    if (hi - lo > 1) { const KArgs ka = kargs(); (void)xcd_barrier_post((unsigned*)(ka->ws + WS_CTL) + CW_BAR, (volatile LAS unsigned*)(ldsp + MISC_OFF) + 8); }
#ifndef DUPMASK
#define DUPMASK 0
#endif
#define REP(b) for (int rep_ = 0; rep_ < (((DUPMASK >> (b)) & 1) ? 2 : 1); ++rep_)
#define IN(k) (lo <= (k) && (k) < hi)
#define SEAM(k) do { if (IN(k) && IN((k) + 1)) { XcdBarrier bar_; bar_.bar = (unsigned*)(kargs()->ws + WS_CTL) + CW_BAR; bar_.x = xb_xcc_id(); bar_.st = (volatile LAS unsigned*)(ldsp + MISC_OFF) + 8; xcd_barrier(bar_); } } while (0)

    if (IN(0)) { REP(0) { ENV(); p0_prologue(ka, ws, gtid, nthr, gw, ngw, lane, ldsp + RING_OFF + wave * 4096); } SEAM(0);
        if (IN(1)) {
            if (threadIdx.x == 0) { unsigned* ctl0 = (unsigned*)(kargs()->ws + WS_CTL); bool ok = gridDim.x == 256;
                for (unsigned x = 0; x < 16; ++x) ok = ok && xb_ld(&ctl0[CW_RANK + 64 * x]) == (x < 8 ? 32u : 0u);
                ((volatile LAS unsigned*)(ldsp + MISC_OFF))[18] = ok ? 1u : 0u; }
            __syncthreads(); } }
    if (IN(1)) {
        REP(1) { ENV(); pg8::Gemm g{(const bf16*)(ws + WS_PWT), (const bf16*)(ws + WS_WUNT), 2048, DM, 256, 256, (size_t)DM * 256 * 2}; pg8::StaticOrder S; S.init(2048, DM, G, bx);
          pg8::EpiFold E{(bf16*)(ws + WS_W + W_IN), W_LAYER / 2};
          pg8::gemm_phase<pg8::EpiFold, pg8::StaticOrder, true>(ldsp + RING_OFF, g, S, E); }
        SEAM(1);
    }
    for (int l = 0; l < DEPTH; ++l) {
        const int pb = 2 + 6 * l;
        if (IN(pb)) {
            REP(2) { ENV(); pg8::Gemm g{(const bf16*)(ws + WS_HN), (const bf16*)(ws + WS_W + (size_t)l * W_LAYER + W_IN), M, NIN, DM, LDH, 0}; pg8::StaticOrder S; S.init(M, NIN, G, bx);
              pg8::EpiProj E{(bf16*)(ws + WS_PROJ), (const float*)(ws + WS_COSA), (const float*)(ws + WS_SINA), (const float*)(ws + WS_COSB), (const float*)(ws + WS_SINB), (const pg8::ss_t*)(ws + WS_SS) + l * M};
              pg8::gemm_phase<pg8::EpiProj, pg8::StaticOrder, true>(ldsp + RING_OFF, g, S, E); }
            SEAM(pb);
        }
        if (IN(pb + 1)) {
            REP(3) { ENV(); attn128::attn_phase((char*)lds + RING_OFF, (const attn128::bf16*)(ws + WS_PROJ), (attn128::bf16*)(ws + WS_OC), vcu, G); }
            REP(4) { ENV(); for (int T = gw; T < 2 * 9 * 128; T += ngw) dil_tile((const bf16*)(ws + WS_PROJ), (bf16*)(ws + WS_MIX), (float*)(ws + WS_LSE), T, (LAS char*)(ldsp + RING_OFF + wave * 8192), lane); }
            REP(5) { ENV(); mixer_cd((const bf16*)(ws + WS_PROJ), (bf16*)(ws + WS_MIX), ka->in[9] + l * 3 * 896, gtid, nthr); }
            SEAM(pb + 1);
        }
        if (IN(pb + 2)) {
            { ENV(); const float lam_init = 0.8f - 0.6f * __expf(-0.3f * (float)l);
              fix_rows((const bf16*)(ws + WS_OC), (bf16*)(ws + WS_MIX), (const float*)(ws + WS_LSE), ka->in[5] + l * 256, ka->in[6] + l * 128, lam_init, gw, ngw, lane); }
            SEAM(pb + 2);
        }
        if (IN(pb + 3)) {
            { ENV(); pg8::Gemm g{(const bf16*)(ws + WS_MIX), (const bf16*)(ws + WS_W + (size_t)l * W_LAYER + W_OUT), M, DM, DM, LDMX, 0}; pg8::StaticOrder S; S.init(M, DM, G, bx);
              pg8::EpiRes E{(bf16*)(ws + WS_HN), LDH, (pg8::ss_t*)(ws + WS_SS) + (DEPTH + l) * M, nullptr, DM};
              pg8::gemm_phase<pg8::EpiRes, pg8::StaticOrder, true>(ldsp + RING_OFF, g, S, E); }
#if defined(PROBE_OUT2)
            { ENV(); pg8::Gemm g{(const bf16*)(ws + WS_MIX), (const bf16*)(ws + WS_W + (size_t)l * W_LAYER + W_OUT), M, DM, DM, LDMX, 0}; pg8::StaticOrder S; S.init(M, DM, G, bx);
              pg8::EpiRes E{(bf16*)(ws + WS_HN), LDH, nullptr, (float*)(ws + WS_ACT), DM};
              pg8::gemm_phase<pg8::EpiRes, pg8::StaticOrder, true, PROBE_OUT2>(ldsp + RING_OFF, g, S, E); }
#endif
            SEAM(pb + 3);
        }
        if (IN(pb + 4)) {
            REP(8) { ENV(); pg8::Gemm g{(const bf16*)(ws + WS_HN), (const bf16*)(ws + WS_W + (size_t)l * W_LAYER + W_UP), M, DFF, DM, LDH, 0}; pg8::StaticOrder S; S.init(M, DFF, G, bx);
              pg8::EpiRelu2 E{(bf16*)(ws + WS_ACT), LDACT, (const pg8::ss_t*)(ws + WS_SS) + (DEPTH + l) * M};
              pg8::gemm_phase<pg8::EpiRelu2, pg8::StaticOrder, true>(ldsp + RING_OFF, g, S, E); }
#if defined(PROBE_UP2)
            { ENV(); pg8::Gemm g{(const bf16*)(ws + WS_HN), (const bf16*)(ws + WS_W + (size_t)l * W_LAYER + W_UP), M, DFF, DM, LDH, 0}; pg8::StaticOrder S; S.init(M, DFF, G, bx);
              pg8::EpiRelu2 E{(bf16*)(ws + WS_PROJ), LDACT, (const pg8::ss_t*)(ws + WS_SS) + (DEPTH + l) * M};
              pg8::gemm_phase<pg8::EpiRelu2, pg8::StaticOrder, true, PROBE_UP2, PROBE_UP2B>(ldsp + RING_OFF, g, S, E); }
#endif
            SEAM(pb + 4);
        }
        if (IN(pb + 5)) {
            { ENV(); pg8::Gemm g{(const bf16*)(ws + WS_ACT), (const bf16*)(ws + WS_W + (size_t)l * W_LAYER + W_DN), M, DM, DFF, LDACT, 0}; pg8::StaticOrder S; S.init(M, DM, G, bx);
              pg8::EpiRes E{(bf16*)(ws + WS_HN), LDH, (pg8::ss_t*)(ws + WS_SS) + (l + 1 < DEPTH ? l + 1 : 2 * DEPTH) * M, nullptr, DM};
              pg8::gemm_phase<pg8::EpiRes, pg8::StaticOrder, true>(ldsp + RING_OFF, g, S, E); }
#if defined(PROBE_DN2)
            { ENV(); pg8::Gemm g{(const bf16*)(ws + WS_ACT), (const bf16*)(ws + WS_W + (size_t)l * W_LAYER + W_DN), M, DM, DFF, LDACT, 0}; pg8::StaticOrder S; S.init(M, DM, G, bx);
              pg8::EpiRes E{(bf16*)(ws + WS_HN), LDH, nullptr, (float*)(ws + WS_PROJ), DM};
              pg8::gemm_phase<pg8::EpiRes, pg8::StaticOrder, true, PROBE_DN2>(ldsp + RING_OFF, g, S, E); }
#endif
            SEAM(pb + 5);
        }
    }
    if (IN(N_PHASES - 1)) { ENV(); rmsnorm_final((const bf16*)(ws + WS_HN), (const pg8::ss_t*)(ws + WS_SS) + 2 * DEPTH * M, ka->out, ka->in[12], gw, ngw, lane); }
#undef IN
#undef SEAM
#undef ENV
#undef REP
}

extern "C" void kernel_launch(void* const* d_in, const int* in_sizes, int n_in, void* d_out, int out_size, void* d_ws, size_t ws_size, hipStream_t stream) {
    static int grid = 0;
    if (grid == 0) {
        if (n_in != 13 || in_sizes[0] != M * DM || out_size != M * DM || ws_size < WS_END) { fprintf(stderr, "kernel_launch: unexpected shapes / workspace (n_in %d, in0 %d, out %d, ws %zu < %zu); nothing launched\n", n_in, n_in > 0 ? in_sizes[0] : -1, out_size, ws_size, (size_t)WS_END); grid = -1; return; }
        int dev = 0, cus = 0, per_cu = 0;
        if (hipGetDevice(&dev) != hipSuccess || hipDeviceGetAttribute(&cus, hipDeviceAttributeMultiprocessorCount, dev) != hipSuccess) { fprintf(stderr, "kernel_launch: device query failed\n"); grid = -1; return; }
        if (hipFuncSetAttribute((const void*)fwd, hipFuncAttributeMaxDynamicSharedMemorySize, LDS_BYTES) != hipSuccess) { fprintf(stderr, "kernel_launch: hipFuncSetAttribute failed\n"); grid = -1; return; }
        if (hipOccupancyMaxActiveBlocksPerMultiprocessor(&per_cu, (const void*)fwd, NWAVES * 64, LDS_BYTES) != hipSuccess || per_cu < 1) fprintf(stderr, "kernel_launch: note: occupancy query reports %d workgroups per CU\n", per_cu);
        (void)hipGetLastError();
        grid = cus;
    }
    if (grid < 0) return;
    if (hipMemsetAsync((char*)d_ws + WS_CTL, 0, CTL_ZERO_BYTES, stream) != hipSuccess) { fprintf(stderr, "kernel_launch: hipMemsetAsync failed\n"); return; }
    Args a{};
    for (int i = 0; i < 13; ++i) a.in[i] = (const float*)d_in[i];
    a.out = (float*)d_out; a.ws = (unsigned char*)d_ws;
#if MK_SPLIT
    for (int p = 0; p < N_PHASES; ++p) { a.ph_lo = p; a.ph_hi = p + 1; hipLaunchKernelGGL(fwd, dim3(grid), dim3(NWAVES * 64), LDS_BYTES, stream, a); }
#else
    a.ph_lo = 0; a.ph_hi = N_PHASES; hipLaunchKernelGGL(fwd, dim3(grid), dim3(NWAVES * 64), LDS_BYTES, stream, a);
#endif
    const hipError_t le = hipPeekAtLastError();
    if (le != hipSuccess) fprintf(stderr, "kernel_launch: launch failed: %s\n", hipGetErrorName(le));
}
```

```cpp
#include <hip/hip_runtime.h>
#include <hip/hip_bf16.h>
#include <cstdio>
#include <cstdint>
#include <cmath>

constexpr int BATCH = 2, SEQ = 4096, DM = 4096, M = BATCH * SEQ, NIN = 10240, DFF = 16384, DEPTH = 2;
constexpr int C_QA = 0, C_KA = 1024, C_VA = 2048, C_QB = 3072, C_KB = 4224, C_VB = 5376, C_U = 6528, C_GB = 7552, C_GC = 8448, C_HD = 9344;
constexpr int LDH = DM, LDP = NIN, LDMX = DM, LDOC = 2048, LDACT = DFF;
constexpr int MIX_A = 0, MIX_B = 1024, MIX_C = 2176, MIX_D = 3200;
constexpr float LOG2E = 1.4426950408889634f;
constexpr float SC_A = 0.125f * LOG2E;
constexpr float SC_B = 0.08838834764831845f * LOG2E;

namespace pg8 {
#define PG8_LAS __attribute__((address_space(3)))
typedef unsigned short bf16_t;
typedef short bf16x8 __attribute__((ext_vector_type(8)));
typedef float f32x4 __attribute__((ext_vector_type(4)));
typedef float f32x2 __attribute__((ext_vector_type(2)));
typedef unsigned u32x4 __attribute__((ext_vector_type(4)));
typedef unsigned long long ss_t;
constexpr float SS_SCALE = 16777216.f, SS_INV = 1.f / 16777216.f;
constexpr int BM = 256, BK = 64, HALF = 128, HTB = HALF * BK * 2  , STAGE_BYTES = 8 * HTB, NXCD = 8, WGM = 4;

__host__ __device__ __forceinline__ int lds_byte(int r, int c) { const int st = (r >> 4) * 2 + (c >> 5), rr = r & 15, cc = c & 31, ob = rr * 64 + cc * 2; return st * 1024 + (ob ^ (((ob >> 9) & 1) << 5)); }
__host__ __device__ __forceinline__ void stage_rc(int b, int& R, int& C) { const int st = b / 1024, sb = b % 1024, swz = sb ^ (((sb >> 9) & 1) << 5); R = (st >> 1) * 16 + swz / 64; C = (st & 1) * 32 + (swz % 64) / 2; }
__host__ __device__ __forceinline__ int perm32(int rho) { const int n = rho >> 4, i = rho & 15; return 8 * (i >> 2) + 4 * n + (i & 3); }

__host__ __device__ __forceinline__ size_t img_elem(int r, int c, int K) { const int ob = (r & 15) * 64 + (c & 31) * 2; return ((size_t)((r >> 4) * (K >> 5) + (c >> 5)) * 1024 + (size_t)(ob ^ (((ob >> 9) & 1) << 5))) >> 1; }
__host__ __device__ __forceinline__ int p32inv(int s) { return 16 * ((s >> 2) & 1) + 4 * (s >> 3) + (s & 3); }
__host__ __device__ __forceinline__ int brow(int np) { return (np & ~31) + p32inv(np & 31); }
__device__ __forceinline__ unsigned epi_img_base(int pm, int pn, int wr, int wc, int fr, int fq, int K) {
    return (unsigned)((16 * pm + 4 * wr) * (K >> 5) + 8 * pn + wc) * 512u + (unsigned)(fr * 64 + ((16 * fq) ^ ((fr & 8) << 2))) / 2u; }
struct Unit { int pm, pn; };
struct Gemm { const bf16_t* A; const bf16_t* Bt; int M, N, K, lda; size_t b_pm_stride; };

struct StaticOrder {
    int nM, nN, nwg, G, c;
    __host__ __device__ void init(int M_, int N_, int G_, int c_) { nM = M_ / BM; nN = N_ / BM; nwg = nM * nN; G = G_; c = c_; }
    __host__ __device__ bool next(int i, Unit& u) const {
        const long L = (long)i * G + c; if (L >= nwg) return false;
        int wgid = (int)L; { const int q = nwg / NXCD, r = nwg % NXCD, xcd = wgid % NXCD, off = wgid / NXCD; wgid = (xcd < r ? xcd * (q + 1) : r * (q + 1) + (xcd - r) * q) + off; }
        const int nig = WGM * nN, gid = wgid / nig, fm = gid * WGM, gsz = (nM - fm) < WGM ? (nM - fm) : WGM;
        u.pm = fm + ((wgid % nig) % gsz); u.pn = (wgid % nig) / gsz; return true;
    }
};

typedef __bf16 bf16x2_t __attribute__((ext_vector_type(2)));
__device__ __forceinline__ unsigned cvt_pk_bf16(float lo, float hi) { f32x2 v = {lo, hi}; bf16x2_t b = __builtin_convertvector(v, bf16x2_t); return __builtin_bit_cast(unsigned, b); }
__device__ __forceinline__ u32x4 pack8(const f32x4& a, const f32x4& b) { u32x4 w; w.x = cvt_pk_bf16(a[0], a[1]); w.y = cvt_pk_bf16(a[2], a[3]); w.z = cvt_pk_bf16(b[0], b[1]); w.w = cvt_pk_bf16(b[2], b[3]); return w; }

struct EpiProj {
    static constexpr bool PERM = true;
    bf16_t* O; const float* cosA; const float* sinA; const float* cosB; const float* sinB; const ss_t* ss;
    __device__ __forceinline__ void operator()(const f32x4 (&acc)[2][2][4][2], const Unit& u, int wr, int wc, int fr, int fq) const {
        const int pn = u.pn, row0 = u.pm * BM + wr * 64 + fr;
        float rs[2][4];
#pragma unroll
        for (int ai = 0; ai < 2; ++ai)
#pragma unroll
            for (int m = 0; m < 4; ++m) rs[ai][m] = 1.f / sqrtf((float)ss[row0 + ai * HALF + m * 16] * (SS_INV / DM) + 1e-6f);
        const int type = pn < 8 ? 1 : ((pn >= 12 && pn <= 20) ? 2 : 0);
        if (type == 0) {
            const int col0 = pn * BM + wc * 32 + 8 * fq;
#pragma unroll
            for (int ai = 0; ai < 2; ++ai)
#pragma unroll
                for (int m = 0; m < 4; ++m) { bf16_t* rowp = O + (size_t)(row0 + ai * HALF + m * 16) * LDP + col0;
#pragma unroll
                    for (int bj = 0; bj < 2; ++bj) *(u32x4*)(rowp + bj * HALF) = pack8(acc[ai][bj][m][0] * rs[ai][m], acc[ai][bj][m][1] * rs[ai][m]); }
        } else {
            float sc; int i0, d1, dd, tp; const float *ct, *st;
            if (type == 1) { sc = pn < 4 ? SC_A : 1.f; i0 = 8 * fq; d1 = pn * BM + 64 * wc + i0; dd = 32; tp = 32; ct = cosA; st = sinA; }
            else { const bool isq = (pn < 16) || (pn == 16 && wc < 2); sc = isq ? SC_B : 1.f; i0 = 32 * (wc & 1) + 8 * fq; d1 = pn * BM + 128 * (wc >> 1) + i0; dd = 64; tp = 64; ct = cosB; st = sinB; }
#pragma unroll
            for (int ai = 0; ai < 2; ++ai)
#pragma unroll
                for (int m = 0; m < 4; ++m) { const int row = row0 + ai * HALF + m * 16, pos = row & (SEQ - 1); const float scr = sc * rs[ai][m];
                    const f32x4 c0 = *(const f32x4*)(ct + pos * tp + i0), c1 = *(const f32x4*)(ct + pos * tp + i0 + 4), s0 = *(const f32x4*)(st + pos * tp + i0), s1 = *(const f32x4*)(st + pos * tp + i0 + 4);
                    const f32x4 x10 = acc[ai][0][m][0], x11 = acc[ai][0][m][1], x20 = acc[ai][1][m][0], x21 = acc[ai][1][m][1];
                    const f32x4 a0 = (x10 * c0 - x20 * s0) * scr, a1 = (x11 * c1 - x21 * s1) * scr, b0 = (x10 * s0 + x20 * c0) * scr, b1 = (x11 * s1 + x21 * c1) * scr;
                    bf16_t* rowp = O + (size_t)row * LDP + d1;
                    *(u32x4*)(rowp) = pack8(a0, a1); *(u32x4*)(rowp + dd) = pack8(b0, b1); }
        }
    }
};
struct EpiRelu2 {
    static constexpr bool PERM = true;
    bf16_t* O; int Kact; const ss_t* ss;
    __device__ __forceinline__ void operator()(const f32x4 (&acc)[2][2][4][2], const Unit& u, int wr, int wc, int fr, int fq) const {
        const int row0 = u.pm * BM + wr * 64 + fr; const unsigned base = epi_img_base(u.pm, u.pn, wr, wc, fr, fq, Kact); const unsigned kb = (unsigned)(Kact >> 5) * 512u;
#pragma unroll
        for (int ai = 0; ai < 2; ++ai)
#pragma unroll
            for (int m = 0; m < 4; ++m) { const float r2 = 1.f / ((float)ss[row0 + ai * HALF + m * 16] * (SS_INV / DM) + 1e-6f);
#pragma unroll
                for (int bj = 0; bj < 2; ++bj) { f32x4 v0 = acc[ai][bj][m][0], v1 = acc[ai][bj][m][1];
                    v0 = __builtin_elementwise_max(v0, (f32x4){0.f, 0.f, 0.f, 0.f}); v1 = __builtin_elementwise_max(v1, (f32x4){0.f, 0.f, 0.f, 0.f}); v0 = v0 * v0 * r2; v1 = v1 * v1 * r2;
                    *(u32x4*)(O + (size_t)(base + (unsigned)(8 * ai + m) * kb + (unsigned)(4 * bj) * 512u)) = pack8(v0, v1); } }
    }
};
struct EpiRes {
    static constexpr bool PERM = true;
    bf16_t* xb; int ldh; ss_t* ss; float* outf; int ldc;
    __device__ __forceinline__ void operator()(const f32x4 (&acc)[2][2][4][2], const Unit& u, int wr, int wc, int fr, int fq) const {
        const int row0 = u.pm * BM + wr * 64 + fr, col0 = u.pn * BM + wc * 32 + 8 * fq; const bool LAST = outf != nullptr; const unsigned base = epi_img_base(u.pm, u.pn, wr, wc, fr, fq, DM);
#pragma unroll
        for (int ai = 0; ai < 2; ++ai)
#pragma unroll
            for (int m = 0; m < 4; ++m) { const int row = row0 + ai * HALF + m * 16; float sq = 0.f;
#pragma unroll
                for (int bj = 0; bj < 2; ++bj) { bf16_t* xp = xb + (size_t)(base + (unsigned)(8 * ai + m) * (unsigned)(DM / 32) * 512u + (unsigned)(4 * bj) * 512u); const u32x4 w = *(const u32x4*)xp;
                    const f32x4 r0 = {__uint_as_float(w.x << 16), __uint_as_float(w.x & 0xffff0000u), __uint_as_float(w.y << 16), __uint_as_float(w.y & 0xffff0000u)};
                    const f32x4 r1 = {__uint_as_float(w.z << 16), __uint_as_float(w.z & 0xffff0000u), __uint_as_float(w.w << 16), __uint_as_float(w.w & 0xffff0000u)};
                    const f32x4 x0 = r0 + acc[ai][bj][m][0], x1 = r1 + acc[ai][bj][m][1];
                    if (LAST) { float* op = outf + (size_t)row * ldc + col0 + bj * HALF; *(f32x4*)op = x0; *(f32x4*)(op + 4) = x1; }
                    else { *(u32x4*)xp = pack8(x0, x1);
                        sq += (x0[0] * x0[0] + x0[1] * x0[1]) + (x0[2] * x0[2] + x0[3] * x0[3]) + (x1[0] * x1[0] + x1[1] * x1[1]) + (x1[2] * x1[2] + x1[3] * x1[3]); } }
                if (!LAST) { sq += __shfl_xor(sq, 16); sq += __shfl_xor(sq, 32); if (fq == 0) atomicAdd(ss + row, (ss_t)(sq * SS_SCALE)); } }
    }
};
struct EpiFold {
    static constexpr bool PERM = true;
    bf16_t* W0; size_t layer_stride;
    __device__ __forceinline__ void operator()(const f32x4 (&acc)[2][2][4][2], const Unit& u, int wr, int wc, int fr, int fq) const {
        bf16_t* W = W0 + (size_t)(u.pm >> 2) * layer_stride; const int n0 = C_U + (u.pm & 3) * 256 + wr * 64;
        const unsigned rb0 = (unsigned)(n0 >> 4) + ((fr >> 2) & 1), rl = 4 * (fr >> 3) + (fr & 3), cb0 = (unsigned)(u.pn * 8 + wc);
        const unsigned base_e = (rb0 * (DM / 32) + cb0) * 512u + (rl * 64u + 16u * fq) / 2u, base_o = (rb0 * (DM / 32) + cb0) * 512u + ((rl + 8u) * 64u + 16u * (fq ^ 2)) / 2u;
#pragma unroll
        for (int ai = 0; ai < 2; ++ai)
#pragma unroll
            for (int m = 0; m < 4; ++m)
#pragma unroll
                for (int bj = 0; bj < 2; ++bj) { const unsigned off = ((m & 1) ? base_o : base_e) + (unsigned)((8 * ai + 2 * (m >> 1)) * (DM / 32) + 4 * bj) * 512u;
                    *(u32x4*)(W + off) = pack8(acc[ai][bj][m][0], acc[ai][bj][m][1]); }
    }
};

template <class Epi, class Sched, bool ALIGN_EPI, int LMASK = -1, int LMASKB = LMASK>
__device__ __forceinline__ void gemm_phase(PG8_LAS unsigned char* lds, const Gemm g, const Sched& S, const Epi& E) {
    int tid = threadIdx.x; asm volatile("" : "+v"(tid));
    const int wid = __builtin_amdgcn_readfirstlane(tid >> 6), lane = tid & 63, wr = wid >> 2, wc = wid & 3, fr = lane & 15, fq = lane >> 4;
    const int K = g.K, nt = K / BK;
    unsigned voffA[2], voffB[2];
#pragma unroll
    for (int i = 0; i < 2; ++i) { int R, C; stage_rc(tid * 16 + i * 8192, R, C); const int Rb = Epi::PERM ? ((R & ~31) + perm32(R & 31)) : R;
        voffB[i] = (unsigned)(((R >> 4) * (K / 32) + (C >> 5)) * 1024 + ((tid * 16) & 1023)); voffA[i] = voffB[i]; (void)Rb; }
    const size_t kstepA = (size_t)2048, hstepA = (size_t)HALF * K * 2, tstepA = 2 * hstepA;
    const size_t kstepB = (size_t)2048, hstepB = (size_t)HALF * K * 2, tstepB = 2 * hstepB;
    const unsigned ldsw = (unsigned)wid * 1024u;
    const int aoff = lds_byte(wr * 64 + fr, fq * 8), boff = lds_byte(wc * 32 + fr, fq * 8);
#define PG8_SA(b, h) (((b) * 2 + (h)) * HTB)
#define PG8_SB(b, h) ((4 + (b) * 2 + (h)) * HTB)
#define PG8_STAGE(bufoff, gbase, voff) do { _Pragma("unroll") for (int _i = 0; _i < 2; ++_i) \
        __builtin_amdgcn_global_load_lds((const unsigned*)((const char*)(gbase) + (voff)[_i]), (PG8_LAS unsigned*)(lds + (bufoff) + ldsw + _i * 8192), 16, 0, 0); } while (0)
#define PG8_LDA(dst, b, h) do { _Pragma("unroll") for (int m = 0; m < 4; ++m) _Pragma("unroll") for (int k = 0; k < 2; ++k) dst[m][k] = *(const PG8_LAS bf16x8*)(lds + PG8_SA(b, h) + aoff + m * 2048 + k * 1024); } while (0)
#define PG8_LDB(dst, b, h) do { _Pragma("unroll") for (int n = 0; n < 2; ++n) _Pragma("unroll") for (int k = 0; k < 2; ++k) dst[n][k] = *(const PG8_LAS bf16x8*)(lds + PG8_SB(b, h) + boff + n * 2048 + k * 1024); } while (0)
#define PG8_MMA(ai, bj, At, Bt) do { __builtin_amdgcn_s_setprio(1); _Pragma("unroll") for (int m = 0; m < 4; ++m) _Pragma("unroll") for (int n = 0; n < 2; ++n) _Pragma("unroll") for (int k = 0; k < 2; ++k) \
        acc[ai][bj][m][n] = __builtin_amdgcn_mfma_f32_16x16x32_bf16(Bt[n][k], At[m][k], acc[ai][bj][m][n], 0, 0, 0); __builtin_amdgcn_s_setprio(0); } while (0)
#define PG8_WAIT_V(n) asm volatile("s_waitcnt vmcnt(" #n ")" ::: "memory")
#define PG8_WAIT_L(n) asm volatile("s_waitcnt lgkmcnt(" #n ")" ::: "memory")
#define PG8_BAR __builtin_amdgcn_s_barrier()
#define PG8_SCHED __builtin_amdgcn_sched_barrier(0)
    Unit cur, nxt; int ui = 0;
    if (!S.next(0, cur)) return;
    f32x4 acc[2][2][4][2];
#pragma unroll
    for (int a = 0; a < 2; ++a)
#pragma unroll
        for (int b = 0; b < 2; ++b)
#pragma unroll
            for (int m = 0; m < 4; ++m)
#pragma unroll
                for (int n = 0; n < 2; ++n) acc[a][b][m][n] = (f32x4){0.f, 0.f, 0.f, 0.f};
    bf16x8 At[4][2], B0[2][2], B1[2][2];
    const char* cA = (const char*)g.A + (size_t)(cur.pm & LMASK) * tstepA; const char* cB = (const char*)g.Bt + (size_t)cur.pm * g.b_pm_stride + (size_t)(cur.pn & LMASKB) * tstepB;
    PG8_STAGE(PG8_SB(0, 0), cB, voffB); PG8_STAGE(PG8_SB(0, 1), cB + hstepB, voffB); PG8_STAGE(PG8_SA(0, 0), cA, voffA); PG8_STAGE(PG8_SA(0, 1), cA + hstepA, voffA);
    if (wr == 1) PG8_BAR;
    PG8_WAIT_V(2); PG8_BAR;
    PG8_STAGE(PG8_SB(1, 0), cB + kstepB, voffB); PG8_STAGE(PG8_SA(1, 0), cA + kstepA, voffA); PG8_STAGE(PG8_SB(1, 1), cB + hstepB + kstepB, voffB);
    PG8_WAIT_V(6); PG8_BAR;
    for (;;) {
        const bool has_next = S.next(ui + 1, nxt);
        const char* nA = has_next ? (const char*)g.A + (size_t)(nxt.pm & LMASK) * tstepA : cA; const char* nB = has_next ? (const char*)g.Bt + (size_t)nxt.pm * g.b_pm_stride + (size_t)(nxt.pn & LMASKB) * tstepB : cB;
        for (int t = 0; t < nt; t += 2) {
            const bool last = (t == nt - 2);
            const char* a1 = cA + (size_t)(t + 1) * kstepA;
            const char* a2 = last ? nA : cA + (size_t)(t + 2) * kstepA; const char* b2 = last ? nB : cB + (size_t)(t + 2) * kstepB;
            const char* a3 = a2 + kstepA; const char* b3 = b2 + kstepB;
            PG8_LDB(B0, 0, 0); PG8_LDB(B1, 0, 1); PG8_SCHED; PG8_LDA(At, 0, 0); PG8_STAGE(PG8_SA(1, 1), a1 + hstepA, voffA);
            PG8_WAIT_V(8); PG8_WAIT_L(0); PG8_BAR; PG8_MMA(0, 0, At, B0); PG8_MMA(0, 1, At, B1); PG8_BAR; PG8_SCHED;
            PG8_LDA(At, 0, 1); PG8_STAGE(PG8_SB(0, 0), b2, voffB); PG8_STAGE(PG8_SB(0, 1), b2 + hstepB, voffB); PG8_STAGE(PG8_SA(0, 0), a2, voffA);
            PG8_WAIT_V(8); PG8_WAIT_L(0); PG8_BAR; PG8_MMA(1, 0, At, B0); PG8_MMA(1, 1, At, B1); PG8_BAR; PG8_SCHED;
            PG8_LDB(B0, 1, 0); PG8_LDB(B1, 1, 1); PG8_SCHED; PG8_LDA(At, 1, 0); PG8_STAGE(PG8_SA(0, 1), a2 + hstepA, voffA);
            PG8_WAIT_V(8); PG8_WAIT_L(0); PG8_BAR; PG8_MMA(0, 0, At, B0); PG8_MMA(0, 1, At, B1); PG8_BAR; PG8_SCHED;
            PG8_LDA(At, 1, 1); PG8_STAGE(PG8_SB(1, 0), b3, voffB); PG8_STAGE(PG8_SB(1, 1), b3 + hstepB, voffB); PG8_STAGE(PG8_SA(1, 0), a3, voffA);
            PG8_WAIT_V(8); PG8_WAIT_L(0); PG8_BAR; PG8_MMA(1, 0, At, B0); PG8_MMA(1, 1, At, B1); PG8_BAR; PG8_SCHED;
        }
        if constexpr (ALIGN_EPI) { if (wr == 0) PG8_BAR; }
        E(acc, cur, wr, wc, fr, fq);
        if (!has_next) break;
#pragma unroll
        for (int a = 0; a < 2; ++a)
#pragma unroll
            for (int b = 0; b < 2; ++b)
#pragma unroll
                for (int m = 0; m < 4; ++m)
#pragma unroll
                    for (int n = 0; n < 2; ++n) acc[a][b][m][n] = (f32x4){0.f, 0.f, 0.f, 0.f};
        cur = nxt; cA = nA; cB = nB; ++ui;
        if constexpr (ALIGN_EPI) { if (wr == 1) PG8_BAR; }
    }
    PG8_WAIT_V(0);
    if constexpr (!ALIGN_EPI) { if (wr == 0) PG8_BAR; }
    PG8_BAR;
#undef PG8_SA
#undef PG8_SB
#undef PG8_STAGE
#undef PG8_LDA
#undef PG8_LDB
#undef PG8_MMA
#undef PG8_WAIT_V
#undef PG8_WAIT_L
#undef PG8_BAR
#undef PG8_SCHED
}
}
namespace attn128 {
using bf16 = __hip_bfloat16;
typedef short bf16x8 __attribute__((ext_vector_type(8)));
typedef short s16x4 __attribute__((ext_vector_type(4)));
typedef float f32x16 __attribute__((ext_vector_type(16)));
typedef float f32x4 __attribute__((ext_vector_type(4)));
typedef unsigned u32x4 __attribute__((ext_vector_type(4)));
constexpr int D = 128, DK = 64, NW = 8, QBLK = 32, KVBLK = 64, QB = NW * QBLK;
constexpr int QS = ::LDP, KS = ::LDP, VS = ::LDP, OS = ::LDOC;
constexpr int SHM_V = KVBLK * D * 2, SHM_K = KVBLK * D * 2;
constexpr int LDS_BYTES = 2 * SHM_V + 2 * SHM_K + NW * 64 * 4;
constexpr float THR = 11.5f;
#ifndef ATT_NOPRIO
#define ATT_PRIO(x) __builtin_amdgcn_s_setprio(x)
#else
#define ATT_PRIO(x)
#endif
#define KSWZ(row, colB) ((row) * 256 + ((colB) ^ (((row) & 15) << 4)))
#define SBAR() __builtin_amdgcn_sched_barrier(0)
__device__ __forceinline__ int v_st(int k, int c) { const int kk = (k & ~0xC) | ((k & 4) << 1) | ((k & 8) >> 1); return ((kk >> 3) * 4 + (c >> 5)) * 512 + ((kk & 7) * 32 + (c & 31)) * 2; }
__device__ __forceinline__ int v_rd_base(int lane) { return ((lane & 3) << 3) | (((lane >> 2) & 3) << 6) | (((lane >> 4) & 1) << 5) | (((lane >> 5) & 1) << 8); }
constexpr int v_rd_off(int d0, int ks, int half) { return d0 * 512 + ks * 4096 + half * 2048; }
__device__ __forceinline__ int crow(int r, int hi) { return (r & 3) + 8 * (r >> 2) + 4 * hi; }
__device__ __forceinline__ unsigned cvtpk(float lo, float hi) { unsigned r; asm volatile("v_cvt_pk_bf16_f32 %0, %1, %2" : "=v"(r) : "v"(lo), "v"(hi)); return r; }
__device__ __forceinline__ unsigned cvtpk_b(float lo, float hi) { typedef float f2_ __attribute__((ext_vector_type(2))); typedef __bf16 b2_ __attribute__((ext_vector_type(2))); f2_ v = {lo, hi}; return __builtin_bit_cast(unsigned, __builtin_convertvector(v, b2_)); }
__device__ __forceinline__ bf16x8 load8(const bf16* p) { return *reinterpret_cast<const bf16x8*>(p); }
__device__ __forceinline__ void mask_tile(f32x16& p0, f32x16& p1, int dq) {
    const float NEG = -__builtin_inff();
#pragma unroll
    for (int r = 0; r < 16; ++r) { const int c = (r & 3) + 8 * (r >> 2);
        if (dq - c < 0) p0[r] = NEG;
        if (dq - c - 32 < 0) p1[r] = NEG; }
}
__device__ __forceinline__ void partialSM(f32x16& p0, f32x16& p1, float& m_reg, float& mn, float& alpha) {
    float pmax = p0[0]; for (int r = 1; r < 16; ++r) pmax = fmaxf(pmax, p0[r]); for (int r = 0; r < 16; ++r) pmax = fmaxf(pmax, p1[r]);
    { auto rr = __builtin_amdgcn_permlane32_swap(__float_as_uint(pmax), __float_as_uint(pmax), false, false);
      pmax = fmaxf(__uint_as_float(rr[0]), __uint_as_float(rr[1])); }
    if (__builtin_expect(__all((pmax - m_reg) <= THR), 1)) { mn = m_reg; alpha = 1.f; }
    else { mn = fmaxf(m_reg, pmax); alpha = __builtin_amdgcn_exp2f(m_reg - mn); m_reg = mn; }
    for (int r = 0; r < 16; ++r) p0[r] = p0[r] - mn; for (int r = 0; r < 16; ++r) p1[r] = p1[r] - mn;
    for (int r = 0; r < 16; ++r) p0[r] = __builtin_amdgcn_exp2f(p0[r]);
}
__device__ __forceinline__ void finishSM(f32x16& p0, f32x16& p1, bf16x8& pa0, bf16x8& pa1, bf16x8& pa2, bf16x8& pa3) {
    for (int r = 0; r < 16; ++r) p1[r] = __builtin_amdgcn_exp2f(p1[r]);
#define PK4(P, B_, OUT) do { unsigned a0 = cvtpk_b(P[B_+0], P[B_+1]), a1 = cvtpk_b(P[B_+2], P[B_+3]);                          \
        unsigned b0 = cvtpk_b(P[B_+4], P[B_+5]), b1 = cvtpk_b(P[B_+6], P[B_+7]);                                             \
        auto r0 = __builtin_amdgcn_permlane32_swap(a0, b0, false, false); auto r1 = __builtin_amdgcn_permlane32_swap(a1, b1, false, false); \
        u32x4 w = {r0[0], r1[0], r0[1], r1[1]}; OUT = *reinterpret_cast<bf16x8*>(&w); } while (0)
    PK4(p0, 0, pa0); PK4(p0, 8, pa1); PK4(p1, 0, pa2); PK4(p1, 8, pa3);
#undef PK4
}
template <int KB, bool PRIO = true>
__device__ __forceinline__ void qkt(f32x16& p0, f32x16& p1, const char* K_lds, int r32, int hi, const bf16x8* qr) {
    p0 = f32x16{}; p1 = f32x16{}; if (PRIO) ATT_PRIO(1);
#pragma unroll
    for (int d0 = 0; d0 < 4; ++d0) { const char* a = K_lds + KB * SHM_K + KSWZ(r32, (d0 * 16 + hi * 8) * 2);
        bf16x8 b0 = *reinterpret_cast<const bf16x8*>(a);
        bf16x8 b1 = *reinterpret_cast<const bf16x8*>(a + 32 * 256);
        p0 = __builtin_amdgcn_mfma_f32_32x32x16_bf16(b0, qr[d0], p0, 0, 0, 0);
        p1 = __builtin_amdgcn_mfma_f32_32x32x16_bf16(b1, qr[d0], p1, 0, 0, 0); }
    if (PRIO) ATT_PRIO(0);
}
template <int VB>
__device__ __forceinline__ void pv_tile(f32x16* o, int vb0, bf16x8 pa0, bf16x8 pa1, bf16x8 pa2, bf16x8 pa3) {
#define TRRD(dst, off) asm volatile("ds_read_b64_tr_b16 %0, %1 offset:%2" : "=&v"(dst) : "v"(vb0), "i"(off) : "memory")
#define PV_D0(d0) do { s16x4 l0, l1, l2, l3, h0, h1, h2, h3; constexpr int b_ = VB * SHM_V + v_rd_off(d0, 0, 0); \
        TRRD(l0, b_); TRRD(h0, b_ + 2048); TRRD(l1, b_ + 4096); TRRD(h1, b_ + 6144); TRRD(l2, b_ + 8192); TRRD(h2, b_ + 10240); TRRD(l3, b_ + 12288); TRRD(h3, b_ + 14336); \
        asm volatile("s_waitcnt lgkmcnt(0)" ::: "memory"); SBAR();   \
        o[d0] = __builtin_amdgcn_mfma_f32_32x32x16_bf16(pa0, (bf16x8){l0[0], l0[1], l0[2], l0[3], h0[0], h0[1], h0[2], h0[3]}, o[d0], 0, 0, 0);   \
        o[d0] = __builtin_amdgcn_mfma_f32_32x32x16_bf16(pa1, (bf16x8){l1[0], l1[1], l1[2], l1[3], h1[0], h1[1], h1[2], h1[3]}, o[d0], 0, 0, 0);   \
        o[d0] = __builtin_amdgcn_mfma_f32_32x32x16_bf16(pa2, (bf16x8){l2[0], l2[1], l2[2], l2[3], h2[0], h2[1], h2[2], h2[3]}, o[d0], 0, 0, 0);   \
        o[d0] = __builtin_amdgcn_mfma_f32_32x32x16_bf16(pa3, (bf16x8){l3[0], l3[1], l3[2], l3[3], h3[0], h3[1], h3[2], h3[3]}, o[d0], 0, 0, 0); } while (0)
    ATT_PRIO(1); PV_D0(0); PV_D0(1); PV_D0(2); PV_D0(3);
#undef PV_D0
#undef TRRD
    const bf16x8 ones = {16256, 16256, 16256, 16256, 16256, 16256, 16256, 16256};
    o[4] = __builtin_amdgcn_mfma_f32_32x32x16_bf16(pa0, ones, o[4], 0, 0, 0); o[4] = __builtin_amdgcn_mfma_f32_32x32x16_bf16(pa1, ones, o[4], 0, 0, 0);
    o[4] = __builtin_amdgcn_mfma_f32_32x32x16_bf16(pa2, ones, o[4], 0, 0, 0); o[4] = __builtin_amdgcn_mfma_f32_32x32x16_bf16(pa3, ones, o[4], 0, 0, 0); ATT_PRIO(0);
}
__device__ __forceinline__ void partialSM_bf(f32x16& p0, f32x16& p1, float& m_reg, float& alpha) {
    float pmax = p0[0]; for (int r = 1; r < 16; ++r) pmax = fmaxf(pmax, p0[r]); for (int r = 0; r < 16; ++r) pmax = fmaxf(pmax, p1[r]);
    { auto rr = __builtin_amdgcn_permlane32_swap(__float_as_uint(pmax), __float_as_uint(pmax), false, false);
      pmax = fmaxf(__uint_as_float(rr[0]), __uint_as_float(rr[1])); }
    const float mn = (pmax - m_reg > THR) ? pmax : m_reg;
    alpha = __builtin_amdgcn_exp2f(m_reg - mn); m_reg = mn;
    for (int r = 0; r < 16; ++r) p0[r] = p0[r] - mn; for (int r = 0; r < 16; ++r) p1[r] = p1[r] - mn;
    for (int r = 0; r < 16; ++r) p0[r] = __builtin_amdgcn_exp2f(p0[r]);
}
typedef __attribute__((address_space(3))) char lchar;
__device__ __forceinline__ s16x4 vtrb(const lchar* p) { typedef short v4i16_t __attribute__((ext_vector_type(4))); typedef __attribute__((address_space(3))) v4i16_t* lp_t; return __builtin_bit_cast(s16x4, __builtin_amdgcn_ds_read_tr16_b64_v4i16((lp_t)p)); }
template <int VB>
__device__ __forceinline__ void pv_tile_b(f32x16* o, const lchar* vl, bf16x8 pa0, bf16x8 pa1, bf16x8 pa2, bf16x8 pa3) {
#pragma unroll
    for (int d0 = 0; d0 < 4; ++d0) { const lchar* b = vl + VB * SHM_V + v_rd_off(d0, 0, 0);
        const s16x4 l0 = vtrb(b), h0 = vtrb(b + 2048), l1 = vtrb(b + 4096), h1 = vtrb(b + 6144), l2 = vtrb(b + 8192), h2 = vtrb(b + 10240), l3 = vtrb(b + 12288), h3 = vtrb(b + 14336);
        o[d0] = __builtin_amdgcn_mfma_f32_32x32x16_bf16(pa0, (bf16x8){l0[0], l0[1], l0[2], l0[3], h0[0], h0[1], h0[2], h0[3]}, o[d0], 0, 0, 0);
        o[d0] = __builtin_amdgcn_mfma_f32_32x32x16_bf16(pa1, (bf16x8){l1[0], l1[1], l1[2], l1[3], h1[0], h1[1], h1[2], h1[3]}, o[d0], 0, 0, 0);
        o[d0] = __builtin_amdgcn_mfma_f32_32x32x16_bf16(pa2, (bf16x8){l2[0], l2[1], l2[2], l2[3], h2[0], h2[1], h2[2], h2[3]}, o[d0], 0, 0, 0);
        o[d0] = __builtin_amdgcn_mfma_f32_32x32x16_bf16(pa3, (bf16x8){l3[0], l3[1], l3[2], l3[3], h3[0], h3[1], h3[2], h3[3]}, o[d0], 0, 0, 0); }
    const bf16x8 ones = {16256, 16256, 16256, 16256, 16256, 16256, 16256, 16256};
    o[4] = __builtin_amdgcn_mfma_f32_32x32x16_bf16(pa0, ones, o[4], 0, 0, 0); o[4] = __builtin_amdgcn_mfma_f32_32x32x16_bf16(pa1, ones, o[4], 0, 0, 0);
    o[4] = __builtin_amdgcn_mfma_f32_32x32x16_bf16(pa2, ones, o[4], 0, 0, 0); o[4] = __builtin_amdgcn_mfma_f32_32x32x16_bf16(pa3, ones, o[4], 0, 0, 0);
}
struct BlockRef { const bf16* Q; const bf16* K; const bf16* V; bf16* O; int P0; };
struct Seam { bf16x8 qr[4]; bf16x8 st_v0, st_v1, st_k0; };
#define VMW() asm volatile("s_waitcnt vmcnt(0)" ::: "memory")
#define VMWN(n) asm volatile("s_waitcnt vmcnt(%0)" :: "i"(n) : "memory")
#define SLOAD_H(Kp, Vp, k0) do { S.st_v0 = load8((Vp) + (size_t)((k0) + sr) * VS + sc); S.st_v1 = load8((Vp) + (size_t)((k0) + 32 + sr) * VS + sc); \
                                 S.st_k0 = load8((Kp) + (size_t)((k0) + kr) * KS + kc); } while (0)
#define SWRITE_HK(bf) do { *(bf16x8*)(K_lds + (bf) * SHM_K + kws) = S.st_k0; } while (0)
#define SWRITE_HV(bf) do { *(bf16x8*)(V_lds + (bf) * SHM_V + vst0) = S.st_v0; *(bf16x8*)(V_lds + (bf) * SHM_V + vst1) = S.st_v1; } while (0)
#define SWRITE_H(bf) do { SWRITE_HV(bf); SWRITE_HK(bf); } while (0)
__device__ __forceinline__ void causal_prime(const BlockRef& cur, char* lds, Seam& S) {
    int tid = threadIdx.x; asm volatile("" : "+v"(tid));
    const int wid = __builtin_amdgcn_readfirstlane(tid >> 6), lane = tid & 63, r32 = lane & 31, hi = lane >> 5;
    const int sr = tid >> 4, sc = (tid & 15) * 8, kr = tid >> 3, kc = (tid & 7) * 8, kws = KSWZ(kr, kc * 2); char* K_lds = lds + 2 * SHM_V;
    for (int d0 = 0; d0 < 4; ++d0) S.qr[d0] = load8(cur.Q + (size_t)(wid * QBLK + r32) * QS + d0 * 16 + hi * 8);
    SLOAD_H(cur.K, cur.V, 0); VMW(); SWRITE_HK(0);
    __syncthreads();
}
__device__ __forceinline__ void causal_block(const BlockRef& cur, const BlockRef& nxt, char* lds, Seam& S) {
    int tid = threadIdx.x; asm volatile("" : "+v"(tid));
    const int wid = __builtin_amdgcn_readfirstlane(tid >> 6), lane = tid & 63, r32 = lane & 31, hi = lane >> 5;
    const int NT = (cur.P0 + QB) / KVBLK;
    const int qlo = cur.P0 + wid * QBLK, qm = qlo + r32 - 4 * hi;
    char* V_lds = lds; char* K_lds = lds + 2 * SHM_V;
    float* ws = (float*)(lds + 2 * SHM_V + 2 * SHM_K) + wid * 64; float* li_l = ws, * al_l = ws + 32;
    float m_reg = -1e30f; f32x16 o[5] = {};
    const int sr = tid >> 4, sc = (tid & 15) * 8, vst0 = v_st(sr, sc), vst1 = v_st(32 + sr, sc), kr = tid >> 3, kc = (tid & 7) * 8, kws = KSWZ(kr, kc * 2);
    const int vb0 = (int)(uintptr_t)V_lds + v_rd_base(lane);
    const lchar* vl = (const lchar*)(size_t)(unsigned)vb0;
    const bf16* Kh = cur.K; const bf16* Vh = cur.V;
#define RESC(a) do { if (__any((a) < 1.f)) { if (hi == 0) al_l[r32] = (a); asm volatile("s_waitcnt lgkmcnt(0)" ::: "memory");              \
                     for (int d_ = 0; d_ < 5; ++d_) for (int r = 0; r < 16; ++r) o[d_][r] *= al_l[crow(r, hi)]; } } while (0)
#define KBASE(t) ((t) * KVBLK)
#define MASKT(P0_, P1_, t) do { const int kb_ = KBASE(t); if (kb_ + KVBLK - 1 > qlo) mask_tile(P0_, P1_, qm - kb_); } while (0)
#define SEAM_K0() do { VMWN(4); SWRITE_HK(0); SBAR(); } while (0)
    f32x16 pA0, pA1, pB0, pB1; float mnA, mnB, alA, alB; bf16x8 pa0, pa1, pa2, pa3;
    SWRITE_HV(0); SBAR();
    SLOAD_H(Kh, Vh, KBASE(1));
    SBAR(); qkt<0>(pA0, pA1, K_lds, r32, hi, S.qr);
    MASKT(pA0, pA1, 0); partialSM(pA0, pA1, m_reg, mnA, alA);
    VMW(); SWRITE_H(1);
    __syncthreads();
#define SGB(mask, n) __builtin_amdgcn_sched_group_barrier(mask, n, 0)
#define R1_PIPE() do { SGB(0x100, 4); _Pragma("unroll") for (int i_ = 0; i_ < 4; ++i_) { SGB(0x008, 1); SGB(0x402, 5); SGB(0x100, 1); } _Pragma("unroll") for (int i_ = 0; i_ < 4; ++i_) { SGB(0x008, 1); SGB(0x402, 5); } } while (0)
#define R2_PIPE() do { SGB(0x100, 8); _Pragma("unroll") for (int i_ = 0; i_ < 12; ++i_) { SGB(0x008, 1); SGB(0x402, 4); SGB(0x100, 2); } _Pragma("unroll") for (int i_ = 0; i_ < 8; ++i_) { SGB(0x008, 1); SGB(0x402, 4); } } while (0)
#define PIN2(P0_, P1_) asm volatile("" : "+v"(P0_), "+v"(P1_))
#define HALF_STEP(PX0, PX1, mnX, alX, PY0, PY1, alY, t, KB, VB, SB) do {                                                      \
        SBAR(); qkt<KB, false>(PX0, PX1, K_lds, r32, hi, S.qr);                                                               \
        finishSM(PY0, PY1, pa0, pa1, pa2, pa3); R1_PIPE(); SBAR();                                                            \
        if ((t) + 1 < NT) { SLOAD_H(Kh, Vh, KBASE((t) + 1)); SBAR(); }                                                        \
        MASKT(PX0, PX1, (t)); SBAR();                                                                                         \
        pv_tile_b<VB>(o, vl, pa0, pa1, pa2, pa3); partialSM_bf(PX0, PX1, m_reg, alX); R2_PIPE(); PIN2(PX0, PX1); SBAR();      \
        __syncthreads();                                                                                                      \
        if ((t) + 1 < NT) { VMW(); SWRITE_H(SB); }                                                                            \
        RESC(alX); __syncthreads(); } while (0)
    for (int t = 1; t + 1 < NT; t += 2) {
        HALF_STEP(pB0, pB1, mnB, alB, pA0, pA1, alA, t, 1, 0, 0);
        HALF_STEP(pA0, pA1, mnA, alA, pB0, pB1, alB, t + 1, 0, 1, 1);
    }
    SBAR(); qkt<1>(pB0, pB1, K_lds, r32, hi, S.qr); SBAR();
    SLOAD_H(nxt.K, nxt.V, 0); SBAR();
#pragma unroll
    for (int d0 = 0; d0 < 4; ++d0) S.qr[d0] = load8(nxt.Q + (size_t)(wid * QBLK + r32) * QS + d0 * 16 + hi * 8);
    SBAR();
    finishSM(pA0, pA1, pa0, pa1, pa2, pa3); SBAR();
    pv_tile<0>(o, vb0, pa0, pa1, pa2, pa3);
    MASKT(pB0, pB1, NT - 1); partialSM(pB0, pB1, m_reg, mnB, alB); __syncthreads(); RESC(alB);
    finishSM(pB0, pB1, pa0, pa1, pa2, pa3); SBAR(); pv_tile<1>(o, vb0, pa0, pa1, pa2, pa3);
    SBAR(); SEAM_K0();
    float rli[16];
#pragma unroll
    for (int r = 0; r < 16; ++r) rli[r] = __builtin_amdgcn_rcpf(o[4][r]);
    bf16* Ow = cur.O + (size_t)(wid * QBLK) * OS;
    { char* ob = lds + (wid < 4 ? wid * 4096 : 2 * SHM_V + SHM_K + (wid - 4) * 4096);
#pragma unroll
      for (int pass = 0; pass < 2; ++pass) {
#pragma unroll
        for (int dd = 0; dd < 2; ++dd)
#pragma unroll
            for (int r = 0; r < 16; r += 2) { const unsigned w = cvtpk(o[2 * pass + dd][r] * rli[r], o[2 * pass + dd][r + 1] * rli[r + 1]);
                *(unsigned short*)(ob + crow(r, hi) * 128 + (dd * 32 + r32) * 2) = (unsigned short)(w & 0xffffu); *(unsigned short*)(ob + crow(r + 1, hi) * 128 + (dd * 32 + r32) * 2) = (unsigned short)(w >> 16); }
        asm volatile("s_waitcnt lgkmcnt(0)" ::: "memory");
#pragma unroll
        for (int j = 0; j < 4; ++j) { const int R = 8 * j + (lane >> 3); const u32x4 w = *(const u32x4*)(ob + R * 128 + (lane & 7) * 16);
            *(u32x4*)(Ow + (size_t)R * OS + 64 * pass + 8 * (lane & 7)) = w; }
        asm volatile("s_waitcnt lgkmcnt(0)" ::: "memory");
      } }
    __syncthreads();
#undef RESC
#undef KBASE
#undef MASKT
#undef SEAM_K0
#undef HALF_STEP
#undef R2_PIPE
#undef PIN2
#undef R1_PIPE
#undef SGB
}
#undef VMW
#undef VMWN
#undef SLOAD_H
#undef SWRITE_HK
#undef SWRITE_HV
#undef SWRITE_H
__device__ __forceinline__ BlockRef make_ref(const bf16* P, bf16* OC, int p, int pass) {
    const int s = p & 7, bhc = p >> 3, b = bhc >> 4, hc = bhc & 15, qb = pass ? 15 - s : s; BlockRef r;
    const size_t row0 = (size_t)b * ::SEQ;
    r.Q = P + (row0 + (size_t)qb * QB) * QS + ::C_QA + hc * 64; r.K = P + row0 * KS + ::C_KA + hc * 64; r.V = P + row0 * VS + ::C_VA + (hc >> 1) * 128;
    r.O = OC + (row0 + (size_t)qb * QB) * OS + hc * 128; r.P0 = qb * QB; return r;
}
__device__ __forceinline__ void attn_phase(char* lds, const bf16* P, bf16* OC, int vcu, int G) {
    int p = vcu; if (p >= 256) return; int pass = 0;
    BlockRef cur = make_ref(P, OC, p, 0); Seam S;
    causal_prime(cur, lds, S);
    for (;;) {
        const bool more_pass = pass == 0, more_item = p + G < 256, last = !more_pass && !more_item;
        int pn = p, passn = pass + 1; if (!more_pass) { passn = 0; pn = more_item ? p + G : p; }
        const BlockRef nxt = last ? cur : make_ref(P, OC, pn, passn);
        causal_block(cur, nxt, lds, S);
        if (last) break;
        cur = nxt; p = pn; pass = passn;
    }
}
#undef KSWZ
#undef SBAR
}
constexpr int NWAVES = 8;
#ifndef MK_SPLIT
#define MK_SPLIT 0
#endif
constexpr int N_PHASES = 3 + 6 * DEPTH;

constexpr size_t MiB = 1u << 20;
constexpr size_t WS_CTL = 0, CTL_ZERO_BYTES = 1 * MiB;
constexpr size_t WS_SS = 512 * 1024;
constexpr size_t WS_COSA = 1 * MiB, WS_SINA = WS_COSA + 512 * 1024;
constexpr size_t WS_COSB = 2 * MiB, WS_SINB = 3 * MiB;
constexpr size_t WS_LSE = 4 * MiB;
constexpr size_t WS_PWT = 6 * MiB;
constexpr size_t WS_WUNT = 8 * MiB;
constexpr size_t WS_W = 32 * MiB;
constexpr size_t W_IN = 0, W_OUT = 80 * MiB, W_UP = 112 * MiB, W_DN = 240 * MiB, W_LAYER = 368 * MiB;
constexpr size_t WS_HN = WS_W + DEPTH * W_LAYER;
constexpr size_t WS_PROJ = WS_HN + 66 * MiB;
constexpr size_t WS_MIX = WS_PROJ + 162 * MiB;
constexpr size_t WS_OC = WS_MIX + 66 * MiB;
constexpr size_t WS_ACT = WS_OC + 34 * MiB;
constexpr size_t WS_END = WS_ACT + 258 * MiB;
static_assert(WS_HN == 768 * MiB && (size_t)M * LDH * 2 <= 66 * MiB && (size_t)M * LDP * 2 <= 162 * MiB && (size_t)M * LDOC * 2 <= 34 * MiB && (size_t)M * LDACT * 2 <= 258 * MiB && WS_END <= 1400 * MiB, "d_ws map");
constexpr int CW_RANK = 8192;
constexpr int CW_BAR = 4096;

constexpr int RING_OFF = 0, RING_BYTES = 131072;
constexpr int LDSCTL_OFF = RING_BYTES, MISC_OFF = LDSCTL_OFF + 320;
constexpr int LDS_BYTES = 147456;
static_assert(MISC_OFF + 128 <= LDS_BYTES && attn128::LDS_BYTES <= RING_BYTES, "LDS map");

#define LAS __attribute__((address_space(3)))
typedef unsigned short bf16;
typedef unsigned v4u __attribute__((ext_vector_type(4)));
typedef unsigned v2u __attribute__((ext_vector_type(2)));
typedef float f32x4 __attribute__((ext_vector_type(4)));
typedef float f32x16 __attribute__((ext_vector_type(16)));
typedef short bf16x8 __attribute__((ext_vector_type(8)));
typedef short s16x4 __attribute__((ext_vector_type(4)));
using pg8::cvt_pk_bf16;
__device__ __forceinline__ float bf_lo(unsigned u) { return __uint_as_float(u << 16); }
__device__ __forceinline__ float bf_hi(unsigned u) { return __uint_as_float(u & 0xffff0000u); }

#define XB_TMO      128
#define XB_XCNT(j)  (256  + 64 * (j))
#define XB_XSUB(j)  (1280 + 64 * (j))
#define XB_XGEN(j)  (2304 + 64 * (j))
#define XB_TOP      3328
#define XB_TOPGEN   3392
#define XCD_BAR_WORDS 3456
#define XB_SPIN_CAP (1u << 18)

__device__ __forceinline__ unsigned xb_ld(unsigned* p)              { return __hip_atomic_load(p, __ATOMIC_RELAXED, __HIP_MEMORY_SCOPE_AGENT); }
__device__ __forceinline__ unsigned xb_add(unsigned* p, unsigned v) { return __hip_atomic_fetch_add(p, v, __ATOMIC_RELAXED, __HIP_MEMORY_SCOPE_AGENT); }
__device__ __forceinline__ unsigned xb_xcc_id() { return (unsigned)__builtin_amdgcn_s_getreg((3 << 11) | 20) & 0xFu; }
#define XB_SPIN(cond, bar) do { unsigned _sp = 0; while (cond) { __builtin_amdgcn_s_sleep(1); \
    if ((++_sp & 255u) == 0u) { if (xb_ld(&(bar)[XB_TMO])) break; if (_sp > XB_SPIN_CAP) { atomicAdd(&(bar)[XB_TMO], 1u); break; } } } } while (0)

struct XcdBarrier {
    unsigned* bar; unsigned x;
    volatile LAS unsigned* st;
};
__device__ __forceinline__ XcdBarrier xcd_barrier_post(unsigned* bar, volatile LAS unsigned* st) {
    XcdBarrier b; b.bar = bar; b.x = xb_xcc_id(); b.st = st;
    if (threadIdx.x == 0) (void)xb_add(&bar[XB_XCNT(b.x)], 1u);
    return b;
}
__device__ __forceinline__ void xcd_barrier_complete(unsigned* bar, unsigned x, unsigned& nloc, unsigned& nx) {
    const unsigned G = gridDim.x * gridDim.y * gridDim.z;
    unsigned sum, cnt, mine, sp = 0u;
    for (;;) {
        sum = 0u; cnt = 0u; mine = 0u;
#pragma unroll
        for (unsigned j = 0; j < 16; ++j) { const unsigned c = xb_ld(&bar[XB_XCNT(j)]); sum += c; cnt += (c > 0u) ? 1u : 0u; mine = (j == x) ? c : mine; }
        if (sum == G) break;
        __builtin_amdgcn_s_sleep(1);
        if ((++sp & 255u) == 0u) { if (xb_ld(&bar[XB_TMO])) break; if (sp > XB_SPIN_CAP) { atomicAdd(&bar[XB_TMO], 1u); break; } }
    }
    nloc = mine > 0u ? mine : 1u; nx = cnt > 0u ? cnt : 1u;
}
__device__ __forceinline__ void xcd_barrier(const XcdBarrier& b) {
    asm volatile("s_waitcnt vmcnt(0)" ::: "memory");
    __syncthreads();
    if (threadIdx.x == 0) {
        unsigned* bar = b.bar;
        __builtin_amdgcn_s_waitcnt(0);
        unsigned nloc = b.st[0], nx = b.st[1];
        if (nloc == 0u) { xcd_barrier_complete(bar, b.x, nloc, nx); b.st[0] = nloc; b.st[1] = nx; }
        const unsigned old = xb_add(&bar[XB_XSUB(b.x)], 1u);
        const unsigned gen = old / nloc;
        if (old + 1u == (gen + 1u) * nloc) {
            __builtin_amdgcn_fence(__ATOMIC_RELEASE, "agent");
            asm volatile("s_waitcnt vmcnt(0)" ::: "memory");
            const unsigned og = xb_add(&bar[XB_TOP], 1u);
            const unsigned tg = og / nx;
            if (og + 1u == (tg + 1u) * nx) xb_add(&bar[XB_TOPGEN], 1u);
            else XB_SPIN(xb_ld(&bar[XB_TOPGEN]) == tg, bar);
            __builtin_amdgcn_fence(__ATOMIC_ACQUIRE, "agent");
            xb_add(&bar[XB_XGEN(b.x)], 1u);
            asm volatile("s_waitcnt vmcnt(0)" ::: "memory");
        } else {
            XB_SPIN(xb_ld(&bar[XB_XGEN(b.x)]) == gen, bar);
            __builtin_amdgcn_fence(__ATOMIC_ACQUIRE, "agent");
            asm volatile("s_waitcnt vmcnt(0)" ::: "memory");
        }
    }
    __syncthreads();
}

struct Args { const float* in[13]; float* out; unsigned char* ws; int ph_lo, ph_hi; };
__device__ __forceinline__ float wave_sum(float v) {
#pragma unroll
    for (int o = 1; o < 64; o <<= 1) v += __shfl_xor(v, o);
    return v;
}
__device__ __forceinline__ int nperm(int n) {
    const int tile = n >> 8, c = n & 255; int cp = c;
    if (tile < 8) { const int q = c >> 6, i = c & 63; cp = (i < 32) ? 32 * q + i : 128 + 32 * q + (i - 32); }
    else if (tile >= 12 && tile <= 20) { const int u = c >> 7, i = c & 127; cp = (i < 64) ? 64 * u + i : 128 + 64 * u + (i - 64); }
    return tile * 256 + cp;
}
template <int MODE, int K, int N>
__device__ __forceinline__ void conv_blocked(const float* __restrict__ W, bf16* D, const float* __restrict__ gk, unsigned gtid, unsigned nthr, LAS unsigned char* scr  ) {
    constexpr unsigned items = (unsigned)(K >> 5) * (unsigned)N;
    const int lane = (int)(gtid & 63u);
    for (unsigned it = gtid; it < items; it += nthr) {
        const unsigned kb = it / (unsigned)N; const int n = (int)(it - kb * (unsigned)N), k0 = (int)kb * 32;
        if (MODE == 1 && n >= C_U && n < C_GB) continue;
        const float* src = W + (size_t)k0 * N + n;
        float v[32];
#pragma unroll
        for (int i = 0; i < 32; ++i) v[i] = __builtin_nontemporal_load(src + (size_t)i * N);
        if (gk) {
#pragma unroll
            for (int i = 0; i < 32; ++i) v[i] *= gk[k0 + i];
        }
        const int rho = pg8::p32inv(lane & 31), half = lane >> 5;
#pragma unroll
        for (int c = 0; c < 4; ++c) { v4u o; o.x = cvt_pk_bf16(v[8 * c], v[8 * c + 1]); o.y = cvt_pk_bf16(v[8 * c + 2], v[8 * c + 3]); o.z = cvt_pk_bf16(v[8 * c + 4], v[8 * c + 5]); o.w = cvt_pk_bf16(v[8 * c + 6], v[8 * c + 7]);
            *(LAS v4u*)(scr + (half * 32 + rho) * 64 + ((c * 16) ^ ((rho & 8) << 2))) = o; }
        const int nb = n - lane;
#pragma unroll
        for (int i = 0; i < 4; ++i) { const int h2 = i >> 1, b2 = i & 1; const int gp = ((MODE == 1) ? nperm(nb + 32 * h2) : nb + 32 * h2) & ~31;
            const v4u o = *(const LAS v4u*)(scr + (h2 * 32 + b2 * 16) * 64 + lane * 16);
            *(v4u*)((unsigned char*)D + ((size_t)((gp >> 4) + b2) * (K >> 5) + (size_t)(k0 >> 5)) * 1024 + lane * 16) = o; }
        asm volatile("s_waitcnt lgkmcnt(0)" ::: "memory");
    }
}
__device__ __forceinline__ void xb_rows(const float* X, bf16* H, pg8::ss_t* ss, int gw, int ngw, int lane) {
    asm volatile("" : "+v"(lane));
    for (int m = gw; m < M; m += ngw) {
        const f32x4* xr = (const f32x4*)(X + (size_t)m * DM) + lane;
        f32x4 v[16]; float s = 0.f;
#pragma unroll
        for (int j = 0; j < 16; ++j) { v[j] = xr[64 * j]; s += (v[j].x * v[j].x + v[j].y * v[j].y) + (v[j].z * v[j].z + v[j].w * v[j].w); }
        s = wave_sum(s); if (lane == 0) ss[m] = (pg8::ss_t)(s * pg8::SS_SCALE);
#pragma unroll
        for (int j = 0; j < 16; ++j) { v2u o; o.x = cvt_pk_bf16(v[j].x, v[j].y); o.y = cvt_pk_bf16(v[j].z, v[j].w); *(v2u*)(H + pg8::img_elem(m, 4 * (lane + 64 * j), DM)) = o; }
    }
}
__device__ __forceinline__ void rmsnorm_final(const bf16* XB, const pg8::ss_t* __restrict__ ss, float* out, const float* __restrict__ g, int gw, int ngw, int lane) {
    asm volatile("" : "+v"(lane));
    for (int m = gw; m < M; m += ngw) {
        const float rstd = 1.f / sqrtf((float)ss[m] * (pg8::SS_INV / DM) + 1e-6f); f32x4* orow = (f32x4*)(out + (size_t)m * DM) + lane; const f32x4* gr = (const f32x4*)g + lane;
#pragma unroll
        for (int j = 0; j < 16; ++j) { const v2u w = *(const v2u*)(XB + pg8::img_elem(m, 4 * (lane + 64 * j), DM));
            const f32x4 x = {bf_lo(w.x), bf_hi(w.x), bf_lo(w.y), bf_hi(w.y)}; orow[64 * j] = x * rstd * gr[64 * j]; }
    }
}

__device__ __forceinline__ void p0_prologue(const __attribute__((address_space(4))) Args* ka, unsigned char* ws, unsigned gtid, unsigned nthr, int gw, int ngw, int lane, LAS unsigned char* scr) {
    const float* in[13];
#pragma unroll
    for (int i = 0; i < 13; ++i) in[i] = ka->in[i];
    { float* cosA = (float*)(ws + WS_COSA); float* sinA = (float*)(ws + WS_SINA); float* cosB = (float*)(ws + WS_COSB); float* sinB = (float*)(ws + WS_SINB);
      for (unsigned it = gtid; it < (unsigned)SEQ * 96u; it += nthr) { const unsigned pos = it / 96u, j = it - pos * 96u; const bool isA = j < 32u; const int i = isA ? (int)j : (int)j - 32;
          const double inv = exp2(-(double)i * (isA ? (1.0 / 32.0) : (1.0 / 64.0)) * 13.287712379549449);
          double rev = (double)pos * inv * 0.15915494309189535; rev -= rint(rev);
          const float rv = (float)rev, c = __builtin_amdgcn_cosf(rv), s = __builtin_amdgcn_sinf(rv);
          if (isA) { cosA[pos * 32 + i] = c; sinA[pos * 32 + i] = s; } else { cosB[pos * 64 + i] = c; sinB[pos * 64 + i] = s; } } }
    { const float* pw = in[7]; const float* ps = in[8]; bf16* PWT = (bf16*)(ws + WS_PWT);
      for (unsigned it = gtid; it < (unsigned)DEPTH * 4u * 256u * 32u; it += nthr) { const unsigned c8 = it & 31u, d = (it >> 5) & 255u, lg = it >> 13;
          const float sc = ps[lg * 256u + d]; const float* src = pw + ((size_t)lg * 256 + c8 * 8) * 256 + d; float v[8];
#pragma unroll
          for (int i = 0; i < 8; ++i) v[i] = src[(size_t)i * 256] * sc;
          v4u o; o.x = cvt_pk_bf16(v[0], v[1]); o.y = cvt_pk_bf16(v[2], v[3]); o.z = cvt_pk_bf16(v[4], v[5]); o.w = cvt_pk_bf16(v[6], v[7]);
          *(v4u*)(PWT + pg8::img_elem((int)(lg * 256u + d), (int)c8 * 8, 256)) = o; } }
    { for (unsigned it = gtid; it < (unsigned)DEPTH * 4096u * 128u; it += nthr) { const unsigned cc = it & 127u, k = (it >> 7) & 4095u, l = it >> 19, g = cc >> 5, c8 = cc & 31u;
          const float* src = in[1] + ((size_t)l * DM + k) * NIN + C_U + cc * 8; const float gm = in[3][l * DM + k];
          const f32x4 a = *(const f32x4*)src * gm, b = *(const f32x4*)(src + 4) * gm;
          v4u o; o.x = cvt_pk_bf16(a[0], a[1]); o.y = cvt_pk_bf16(a[2], a[3]); o.z = cvt_pk_bf16(b[0], b[1]); o.w = cvt_pk_bf16(b[2], b[3]);
          *(v4u*)((bf16*)(ws + WS_WUNT) + (size_t)(l * 4 + g) * (4096 * 256) + pg8::img_elem(pg8::brow((int)k), (int)c8 * 8, 256)) = o; } }
#ifndef PROBE_P0
#define PROBE_P0 1
#endif
    for (int l2 = 0; l2 < DEPTH * PROBE_P0; ++l2) { const int l = DEPTH - 1 - (l2 % DEPTH);
        unsigned char* wl = ws + WS_W + (size_t)l * W_LAYER;
        conv_blocked<0, DFF, DM>(in[11] + (size_t)l * DFF * DM, (bf16*)(wl + W_DN), nullptr, gtid, nthr, scr);
        conv_blocked<0, DM, DFF>(in[10] + (size_t)l * DM * DFF, (bf16*)(wl + W_UP), in[4] + l * DM, gtid, nthr, scr);
        conv_blocked<0, DM, DM>(in[2] + (size_t)l * DM * DM, (bf16*)(wl + W_OUT), nullptr, gtid, nthr, scr);
        conv_blocked<1, DM, NIN>(in[1] + (size_t)l * DM * NIN, (bf16*)(wl + W_IN), in[3] + l * DM, gtid, nthr, scr);
    }
    xb_rows(in[0], (bf16*)(ws + WS_HN), (pg8::ss_t*)(ws + WS_SS), gw, ngw, lane);
}

__device__ __forceinline__ s16x4 vtr(const LAS char* p) { typedef short v4i16_t __attribute__((ext_vector_type(4))); return __builtin_bit_cast(s16x4, __builtin_amdgcn_ds_read_tr16_b64_v4i16((LAS v4i16_t*)p)); }
__device__ __forceinline__ int crow(int r, int hi) { return (r & 3) + 8 * (r >> 2) + 4 * hi; }
__device__ __forceinline__ void dil_tile(const bf16* __restrict__ P, bf16* MIX, float* LSE, int T, LAS char* vimg, int lane) {
    asm volatile("" : "+v"(lane));
    const int r32 = lane & 31, hi = lane >> 5;
    const int bh = T >> 7, within = T & 127, b = bh / 9, head = bh - 9 * b, gi = head / 3, dsh = 2 * gi;
    const int L32 = 128 >> dsh, r = within >> (7 - dsh), i0 = (within & (L32 - 1)) << 5, j0 = i0 - 128;
    const size_t row0 = (size_t)b * SEQ + r;
    bf16x8 qf[8];
    { const bf16* qp = P + (row0 + ((size_t)(i0 + r32) << dsh)) * LDP + C_QB + head * 128 + 8 * hi;
#pragma unroll
      for (int s = 0; s < 8; ++s) qf[s] = *(const bf16x8*)(qp + 16 * s); }
    f32x16 S[5];
#pragma unroll
    for (int kt = 0; kt < 5; ++kt) {
        int ln = lane; asm volatile("" : "+v"(ln));
#pragma unroll
        for (int it = 0; it < 8; ++it) { const int rr = (ln >> 4) + 4 * it, c16 = ln & 15; const int key = j0 + 32 * kt + rr, kc = key < 0 ? 0 : key;
            __builtin_amdgcn_global_load_lds((const unsigned*)(P + (row0 + ((size_t)kc << dsh)) * LDP + C_KB + head * 128 + 8 * (c16 ^ (rr & 15))), (LAS unsigned*)(vimg + it * 1024), 16, 0, 0); }
        asm volatile("s_waitcnt vmcnt(0)" ::: "memory");
        bf16x8 kf[8];
#pragma unroll
        for (int s = 0; s < 8; ++s) kf[s] = *(const LAS bf16x8*)(vimg + r32 * 256 + (((2 * s + hi) ^ (r32 & 15)) << 4));
        asm volatile("s_waitcnt lgkmcnt(0)" ::: "memory");
        f32x16 a = {};
#pragma unroll
        for (int s = 0; s < 8; ++s) a = __builtin_amdgcn_mfma_f32_32x32x16_bf16(kf[s], qf[s], a, 0, 0, 0);
        S[kt] = a; }
    const int iq = i0 + r32; float mx = -INFINITY;
#pragma unroll
    for (int kt = 0; kt < 5; ++kt)
#pragma unroll
        for (int g = 0; g < 16; ++g) { const int key = j0 + 32 * kt + crow(g, hi); const bool ok = (key >= 0) && (key <= iq) && (key >= iq - 128); const float v = ok ? S[kt][g] : -INFINITY; S[kt][g] = v; mx = fmaxf(mx, v); }
    mx = fmaxf(mx, __shfl_xor(mx, 32));
    float l = 0.f;
#pragma unroll
    for (int kt = 0; kt < 5; ++kt)
#pragma unroll
        for (int g = 0; g < 16; ++g) { const float p = __builtin_amdgcn_exp2f(S[kt][g] - mx); S[kt][g] = p; l += p; }
    l += __shfl_xor(l, 32);
    if (hi == 0) LSE[(row0 + ((size_t)iq << dsh)) * 16 + head] = mx + __builtin_amdgcn_logf(l);
    const float rl = 1.f / l;
    f32x16 O[4] = {};
#pragma unroll
    for (int kt = 0; kt < 5; ++kt) {
#pragma unroll
        for (int it = 0; it < 8; ++it) { const int rr = (lane >> 4) + 4 * it, c16 = lane & 15; const int key = j0 + 32 * kt + rr, kc = key < 0 ? 0 : key;
            const v4u v = *(const v4u*)(P + (row0 + ((size_t)kc << dsh)) * LDP + C_VB + head * 128 + 8 * c16);
            *(LAS v4u*)(vimg + (c16 >> 2) * 2048 + rr * 64 + (c16 & 3) * 16) = v; }
        const LAS char* vb = vimg + ((lane >> 4) & 1) * 32 + (lane & 3) * 8 + (4 * hi + ((lane & 15) >> 2)) * 64;
#pragma unroll
        for (int s2 = 0; s2 < 2; ++s2) {
            v4u pw; pw.x = cvt_pk_bf16(S[kt][8 * s2 + 0] * rl, S[kt][8 * s2 + 1] * rl); pw.y = cvt_pk_bf16(S[kt][8 * s2 + 2] * rl, S[kt][8 * s2 + 3] * rl);
            pw.z = cvt_pk_bf16(S[kt][8 * s2 + 4] * rl, S[kt][8 * s2 + 5] * rl); pw.w = cvt_pk_bf16(S[kt][8 * s2 + 6] * rl, S[kt][8 * s2 + 7] * rl);
            const bf16x8 pa = __builtin_bit_cast(bf16x8, pw);
#pragma unroll
            for (int nb = 0; nb < 4; ++nb) { const s16x4 lo = vtr(vb + nb * 2048 + s2 * 1024), hh = vtr(vb + nb * 2048 + s2 * 1024 + 512);
                const bf16x8 vf = (bf16x8){lo[0], lo[1], lo[2], lo[3], hh[0], hh[1], hh[2], hh[3]};
                O[nb] = __builtin_amdgcn_mfma_f32_32x32x16_bf16(pa, vf, O[nb], 0, 0, 0); } }
    }
#pragma unroll
    for (int nb = 0; nb < 4; ++nb)
#pragma unroll
        for (int g = 0; g < 16; g += 2) { const unsigned w = cvt_pk_bf16(O[nb][g], O[nb][g + 1]);
            *(LAS unsigned short*)(vimg + crow(g, hi) * 256 + (32 * nb + r32) * 2) = (unsigned short)(w & 0xffffu); *(LAS unsigned short*)(vimg + crow(g + 1, hi) * 256 + (32 * nb + r32) * 2) = (unsigned short)(w >> 16); }
    asm volatile("s_waitcnt lgkmcnt(0)" ::: "memory");
#pragma unroll
    for (int j = 0; j < 8; ++j) { const int q = 4 * j + (lane >> 4), c16 = lane & 15; const v4u w = *(const LAS v4u*)(vimg + q * 256 + c16 * 16);
        const int orow = (int)(row0 + ((size_t)(i0 + q) << dsh)); *(v4u*)(MIX + pg8::img_elem(orow, MIX_B + head * 128 + 8 * c16, DM)) = w; }
    asm volatile("s_waitcnt lgkmcnt(0)" ::: "memory");
}

__device__ __forceinline__ void unpack8(const v4u& w, float (&f)[8]) { f[0] = bf_lo(w.x); f[1] = bf_hi(w.x); f[2] = bf_lo(w.y); f[3] = bf_hi(w.y); f[4] = bf_lo(w.z); f[5] = bf_hi(w.z); f[6] = bf_lo(w.w); f[7] = bf_hi(w.w); }
__device__ __forceinline__ void mixer_cd(const bf16* __restrict__ P, bf16* MIX, const float* __restrict__ cw  , unsigned gtid, unsigned nthr) {
    asm volatile("" : "+v"(gtid));
    constexpr int RUN = 16;
    for (unsigned it = gtid; it < (unsigned)(M / RUN) * 256u; it += nthr) {
        const unsigned run = it >> 8, ch = it & 255u; if (ch >= 240u) continue; const int row0 = (int)run * RUN, t0 = row0 & (SEQ - 1);
        if (ch < 128u) {
            const int w = 2 << (ch >> 5); const bf16* p = P + (size_t)row0 * LDP + C_U + ch * 8; const int ocol = MIX_C + (int)ch * 8;
            float acc[8] = {0.f, 0.f, 0.f, 0.f, 0.f, 0.f, 0.f, 0.f};
            if (__builtin_amdgcn_readfirstlane((int)ch) < 64) {
                v4u pf[3];
#pragma unroll
                for (int i = 1; i < 4; ++i) { const bool ok = i < w && t0 - i >= 0; pf[i - 1] = *(const v4u*)(p - (size_t)(ok ? i : 0) * LDP); }
#pragma unroll
                for (int i = 1; i < 4; ++i) { const bool ok = i < w && t0 - i >= 0; float f[8]; unpack8(pf[i - 1], f);
#pragma unroll
                    for (int e = 0; e < 8; ++e) acc[e] += ok ? f[e] : 0.f; }
            } else {
                v4u pf[15];
#pragma unroll
                for (int i = 1; i < 16; ++i) { const bool ok = i < w && t0 - i >= 0; pf[i - 1] = *(const v4u*)(p - (size_t)(ok ? i : 0) * LDP); }
#pragma unroll
                for (int i = 1; i < 16; ++i) { const bool ok = i < w && t0 - i >= 0; float f[8]; unpack8(pf[i - 1], f);
#pragma unroll
                    for (int e = 0; e < 8; ++e) acc[e] += ok ? f[e] : 0.f; }
            }
#pragma unroll 4
            for (int r = 0; r < RUN; ++r) { const int t = t0 + r; float cur[8]; unpack8(*(const v4u*)(p + (size_t)r * LDP), cur);
#pragma unroll
                for (int e = 0; e < 8; ++e) acc[e] += cur[e];
                const int cnt = (t + 1 < w) ? t + 1 : w; const float rc = 1.f / (float)cnt; v4u ov;
                ov.x = cvt_pk_bf16(acc[0] * rc - cur[0], acc[1] * rc - cur[1]); ov.y = cvt_pk_bf16(acc[2] * rc - cur[2], acc[3] * rc - cur[3]);
                ov.z = cvt_pk_bf16(acc[4] * rc - cur[4], acc[5] * rc - cur[5]); ov.w = cvt_pk_bf16(acc[6] * rc - cur[6], acc[7] * rc - cur[7]);
                *(v4u*)(MIX + pg8::img_elem(row0 + r, ocol, DM)) = ov;
                if (t - (w - 1) >= 0) { float f[8]; unpack8(*(const v4u*)(p + (size_t)(r - (w - 1)) * LDP), f);
#pragma unroll
                    for (int e = 0; e < 8; ++e) acc[e] -= f[e]; } }
        } else {
            const unsigned dc = ch - 128u; const bf16* pb = P + (size_t)row0 * LDP + C_GB + dc * 8; const bf16* pc = P + (size_t)row0 * LDP + C_GC + dc * 8; const bf16* ph = P + (size_t)row0 * LDP + C_HD + dc * 8;
            const int ocol = MIX_D + (int)dc * 8;
            float wk[3][8];
#pragma unroll
            for (int k = 0; k < 3; ++k) { const f32x4 a = *(const f32x4*)(cw + k * 896 + dc * 8), b = *(const f32x4*)(cw + k * 896 + dc * 8 + 4);
#pragma unroll
                for (int e = 0; e < 4; ++e) { wk[k][e] = a[e]; wk[k][4 + e] = b[e]; } }
            float z1[8], z2[8];
#pragma unroll
            for (int e = 0; e < 8; ++e) { z1[e] = 0.f; z2[e] = 0.f; }
            if (t0 >= 1) { float c[8], h[8]; unpack8(*(const v4u*)(pc - (size_t)LDP), c); unpack8(*(const v4u*)(ph - (size_t)LDP), h);
#pragma unroll
                for (int e = 0; e < 8; ++e) z1[e] = c[e] * h[e]; }
            if (t0 >= 2) { float c[8], h[8]; unpack8(*(const v4u*)(pc - (size_t)2 * LDP), c); unpack8(*(const v4u*)(ph - (size_t)2 * LDP), h);
#pragma unroll
                for (int e = 0; e < 8; ++e) z2[e] = c[e] * h[e]; }
#pragma unroll 4
            for (int r = 0; r < RUN; ++r) { float c[8], h[8], bb[8]; unpack8(*(const v4u*)(pc + (size_t)r * LDP), c); unpack8(*(const v4u*)(ph + (size_t)r * LDP), h); unpack8(*(const v4u*)(pb + (size_t)r * LDP), bb);
                float y[8];
#pragma unroll
                for (int e = 0; e < 8; ++e) { const float z0 = c[e] * h[e]; y[e] = bb[e] * (wk[0][e] * z2[e] + wk[1][e] * z1[e] + wk[2][e] * z0); z2[e] = z1[e]; z1[e] = z0; }
                v4u ov; ov.x = cvt_pk_bf16(y[0], y[1]); ov.y = cvt_pk_bf16(y[2], y[3]); ov.z = cvt_pk_bf16(y[4], y[5]); ov.w = cvt_pk_bf16(y[6], y[7]);
                *(v4u*)(MIX + pg8::img_elem(row0 + r, ocol, DM)) = ov; }
        }
    }
}

__device__ __forceinline__ void fix_rows(const bf16* __restrict__ OC, bf16* MIX, const float* __restrict__ LSE, const float* __restrict__ lamp  , const float* __restrict__ subln  ,
                                         float lam_init, int gw, int ngw, int lane) {
    asm volatile("" : "+v"(lane));
    const float lam = __expf(wave_sum(lamp[lane] * lamp[64 + lane])) - __expf(wave_sum(lamp[128 + lane] * lamp[192 + lane])) + lam_init;
    const float g0 = subln[2 * lane] * (1.f - lam_init), g1 = subln[2 * lane + 1] * (1.f - lam_init);
    const int j8 = (lane & 15) * 8;
    float gg[8];
#pragma unroll
    for (int i = 0; i < 8; ++i) gg[i] = subln[j8 + i] * (1.f - lam_init);
    (void)g0; (void)g1;
    for (int m = gw; m < M; m += ngw) {
        const bf16* ocr = OC + (size_t)m * LDOC;
        v4u av[2], bv[2], mv[3];
#pragma unroll
        for (int p = 0; p < 2; ++p) { const int h = 4 * p + (lane >> 4); av[p] = *(const v4u*)(ocr + h * 256 + j8); bv[p] = *(const v4u*)(ocr + h * 256 + 128 + j8); }
        const float lv = LSE[(size_t)m * 16 + (lane < 9 ? lane : 0)];
#pragma unroll
        for (int q = 0; q < 3; ++q) { const int slot = 64 * q + lane, h9 = slot < 144 ? (slot >> 4) : 8; mv[q] = *(const v4u*)(MIX + pg8::img_elem(m, MIX_B + h9 * 128 + j8, DM)); }
#pragma unroll
        for (int p = 0; p < 2; ++p) { const int h = 4 * p + (lane >> 4); float af[8], bf[8], o[8]; unpack8(av[p], af); unpack8(bv[p], bf); float sq = 0.f;
#pragma unroll
            for (int i = 0; i < 8; ++i) { o[i] = af[i] - lam * bf[i]; sq += o[i] * o[i]; }
            sq += __shfl_xor(sq, 1); sq += __shfl_xor(sq, 2); sq += __shfl_xor(sq, 4); sq += __shfl_xor(sq, 8);
            const float rn = 1.f / sqrtf(sq * (1.f / 128.f) + 1e-5f);
            v4u ov; ov.x = cvt_pk_bf16(o[0] * rn * gg[0], o[1] * rn * gg[1]); ov.y = cvt_pk_bf16(o[2] * rn * gg[2], o[3] * rn * gg[3]); ov.z = cvt_pk_bf16(o[4] * rn * gg[4], o[5] * rn * gg[5]); ov.w = cvt_pk_bf16(o[6] * rn * gg[6], o[7] * rn * gg[7]);
            *(v4u*)(MIX + pg8::img_elem(m, h * 128 + j8, DM)) = ov; }
#pragma unroll
        for (int q = 0; q < 3; ++q) { const int slot = 64 * q + lane; const bool act = slot < 144; const int h9 = act ? (slot >> 4) : 8, hh = h9 % 3;
            const float l0 = __shfl(lv, hh), l1 = __shfl(lv, 3 + hh), l2 = __shfl(lv, 6 + hh), own = __shfl(lv, h9), mm = fmaxf(l0, fmaxf(l1, l2));
            const float al = __builtin_amdgcn_exp2f(own - mm) / (__builtin_amdgcn_exp2f(l0 - mm) + __builtin_amdgcn_exp2f(l1 - mm) + __builtin_amdgcn_exp2f(l2 - mm));
            float f[8]; unpack8(mv[q], f); v4u ov; ov.x = cvt_pk_bf16(f[0] * al, f[1] * al); ov.y = cvt_pk_bf16(f[2] * al, f[3] * al); ov.z = cvt_pk_bf16(f[4] * al, f[5] * al); ov.w = cvt_pk_bf16(f[6] * al, f[7] * al);
            if (act) *(v4u*)(MIX + pg8::img_elem(m, MIX_B + h9 * 128 + j8, DM)) = ov; }
    }
}

typedef const __attribute__((address_space(4))) Args* KArgs;
__device__ __forceinline__ KArgs kargs() { KArgs p = (KArgs)__builtin_amdgcn_kernarg_segment_ptr(); asm volatile("" : "+s"(p)); return p; }
#define ENV() \
    const KArgs ka = kargs(); unsigned char* const ws = ka->ws; \
    int tid = threadIdx.x; asm volatile("" : "+v"(tid)); \
    const int lane = tid & 63, wave = __builtin_amdgcn_readfirstlane(tid >> 6); \
    const int G = gridDim.x; volatile LAS unsigned* const MISCv = (volatile LAS unsigned*)(ldsp + MISC_OFF); \
    const int bx = MISCv[18] ? (int)(MISCv[17] * 8u + MISCv[16]) : (int)blockIdx.x;        \
    const int vcu = (G % 8 == 0) ? (bx % 8) * (G / 8) + bx / 8 : bx; \
    const unsigned gtid = (unsigned)vcu * 512u + (unsigned)tid, nthr = (unsigned)G * 512u; const int gw = vcu * NWAVES + wave, ngw = G * NWAVES; \
    (void)lane; (void)gtid; (void)nthr; (void)gw; (void)ngw; (void)bx; (void)ws
__global__ void __launch_bounds__(NWAVES * 64, 2) fwd(Args args_unused) {
    extern __shared__ __attribute__((aligned(16))) unsigned char lds[];
    LAS unsigned char* const ldsp = (LAS unsigned char*)lds;
    { const int tid0 = threadIdx.x; for (int u = tid0; u < (LDS_BYTES - LDSCTL_OFF) / 4; u += NWAVES * 64) ((LAS unsigned*)(ldsp + LDSCTL_OFF))[u] = 0u; }
    __syncthreads();
    int lo, hi; { const KArgs ka = kargs(); lo = ka->ph_lo; hi = ka->ph_hi; }
    if (threadIdx.x == 0) { unsigned* ctl0 = (unsigned*)(kargs()->ws + WS_CTL); const unsigned x = xb_xcc_id(); volatile LAS unsigned* Mv = (volatile LAS unsigned*)(ldsp + MISC_OFF);
        Mv[16] = x; Mv[17] = xb_add(&ctl0[CW_RANK + 64 * x], 1u); }
    __syncthreads();
    if (hi - lo > 1) { const KArgs ka = kargs(); (void)xcd_barrier_post((unsigned*)(ka->ws + WS_CTL) + CW_BAR, (volatile LAS unsigned*)(ldsp + MISC_OFF) + 8); }
#ifndef DUPMASK
#define DUPMASK 0
#endif
#define REP(b) for (int rep_ = 0; rep_ < (((DUPMASK >> (b)) & 1) ? 2 : 1); ++rep_)
#define IN(k) (lo <= (k) && (k) < hi)
#define SEAM(k) do { if (IN(k) && IN((k) + 1)) { XcdBarrier bar_; bar_.bar = (unsigned*)(kargs()->ws + WS_CTL) + CW_BAR; bar_.x = xb_xcc_id(); bar_.st = (volatile LAS unsigned*)(ldsp + MISC_OFF) + 8; xcd_barrier(bar_); } } while (0)

    if (IN(0)) { REP(0) { ENV(); p0_prologue(ka, ws, gtid, nthr, gw, ngw, lane, ldsp + RING_OFF + wave * 4096); } SEAM(0);
        if (IN(1)) {
            if (threadIdx.x == 0) { unsigned* ctl0 = (unsigned*)(kargs()->ws + WS_CTL); bool ok = gridDim.x == 256;
                for (unsigned x = 0; x < 16; ++x) ok = ok && xb_ld(&ctl0[CW_RANK + 64 * x]) == (x < 8 ? 32u : 0u);
                ((volatile LAS unsigned*)(ldsp + MISC_OFF))[18] = ok ? 1u : 0u; }
            __syncthreads(); } }
    if (IN(1)) {
        REP(1) { ENV(); pg8::Gemm g{(const bf16*)(ws + WS_PWT), (const bf16*)(ws + WS_WUNT), 2048, DM, 256, 256, (size_t)DM * 256 * 2}; pg8::StaticOrder S; S.init(2048, DM, G, bx);
          pg8::EpiFold E{(bf16*)(ws + WS_W + W_IN), W_LAYER / 2};
          pg8::gemm_phase<pg8::EpiFold, pg8::StaticOrder, true>(ldsp + RING_OFF, g, S, E); }
        SEAM(1);
    }
    for (int l = 0; l < DEPTH; ++l) {
        const int pb = 2 + 6 * l;
        if (IN(pb)) {
            REP(2) { ENV(); pg8::Gemm g{(const bf16*)(ws + WS_HN), (const bf16*)(ws + WS_W + (size_t)l * W_LAYER + W_IN), M, NIN, DM, LDH, 0}; pg8::StaticOrder S; S.init(M, NIN, G, bx);
              pg8::EpiProj E{(bf16*)(ws + WS_PROJ), (const float*)(ws + WS_COSA), (const float*)(ws + WS_SINA), (const float*)(ws + WS_COSB), (const float*)(ws + WS_SINB), (const pg8::ss_t*)(ws + WS_SS) + l * M};
              pg8::gemm_phase<pg8::EpiProj, pg8::StaticOrder, true>(ldsp + RING_OFF, g, S, E); }
            SEAM(pb);
        }
        if (IN(pb + 1)) {
            REP(3) { ENV(); attn128::attn_phase((char*)lds + RING_OFF, (const attn128::bf16*)(ws + WS_PROJ), (attn128::bf16*)(ws + WS_OC), vcu, G); }
            REP(4) { ENV(); for (int T = gw; T < 2 * 9 * 128; T += ngw) dil_tile((const bf16*)(ws + WS_PROJ), (bf16*)(ws + WS_MIX), (float*)(ws + WS_LSE), T, (LAS char*)(ldsp + RING_OFF + wave * 8192), lane); }
            REP(5) { ENV(); mixer_cd((const bf16*)(ws + WS_PROJ), (bf16*)(ws + WS_MIX), ka->in[9] + l * 3 * 896, gtid, nthr); }
            SEAM(pb + 1);
        }
        if (IN(pb + 2)) {
            { ENV(); const float lam_init = 0.8f - 0.6f * __expf(-0.3f * (float)l);
              fix_rows((const bf16*)(ws + WS_OC), (bf16*)(ws + WS_MIX), (const float*)(ws + WS_LSE), ka->in[5] + l * 256, ka->in[6] + l * 128, lam_init, gw, ngw, lane); }
            SEAM(pb + 2);
        }
        if (IN(pb + 3)) {
            { ENV(); pg8::Gemm g{(const bf16*)(ws + WS_MIX), (const bf16*)(ws + WS_W + (size_t)l * W_LAYER + W_OUT), M, DM, DM, LDMX, 0}; pg8::StaticOrder S; S.init(M, DM, G, bx);
              pg8::EpiRes E{(bf16*)(ws + WS_HN), LDH, (pg8::ss_t*)(ws + WS_SS) + (DEPTH + l) * M, nullptr, DM};
              pg8::gemm_phase<pg8::EpiRes, pg8::StaticOrder, true>(ldsp + RING_OFF, g, S, E); }
#if defined(PROBE_OUT2)
            { ENV(); pg8::Gemm g{(const bf16*)(ws + WS_MIX), (const bf16*)(ws + WS_W + (size_t)l * W_LAYER + W_OUT), M, DM, DM, LDMX, 0}; pg8::StaticOrder S; S.init(M, DM, G, bx);
              pg8::EpiRes E{(bf16*)(ws + WS_HN), LDH, nullptr, (float*)(ws + WS_ACT), DM};
              pg8::gemm_phase<pg8::EpiRes, pg8::StaticOrder, true, PROBE_OUT2>(ldsp + RING_OFF, g, S, E); }
#endif
            SEAM(pb + 3);
        }
        if (IN(pb + 4)) {
            REP(8) { ENV(); pg8::Gemm g{(const bf16*)(ws + WS_HN), (const bf16*)(ws + WS_W + (size_t)l * W_LAYER + W_UP), M, DFF, DM, LDH, 0}; pg8::StaticOrder S; S.init(M, DFF, G, bx);
              pg8::EpiRelu2 E{(bf16*)(ws + WS_ACT), LDACT, (const pg8::ss_t*)(ws + WS_SS) + (DEPTH + l) * M};
              pg8::gemm_phase<pg8::EpiRelu2, pg8::StaticOrder, true>(ldsp + RING_OFF, g, S, E); }
#if defined(PROBE_UP2)
            { ENV(); pg8::Gemm g{(const bf16*)(ws + WS_HN), (const bf16*)(ws + WS_W + (size_t)l * W_LAYER + W_UP), M, DFF, DM, LDH, 0}; pg8::StaticOrder S; S.init(M, DFF, G, bx);
              pg8::EpiRelu2 E{(bf16*)(ws + WS_PROJ), LDACT, (const pg8::ss_t*)(ws + WS_SS) + (DEPTH + l) * M};
              pg8::gemm_phase<pg8::EpiRelu2, pg8::StaticOrder, true, PROBE_UP2, PROBE_UP2B>(ldsp + RING_OFF, g, S, E); }
#endif
            SEAM(pb + 4);
        }
        if (IN(pb + 5)) {
            { ENV(); pg8::Gemm g{(const bf16*)(ws + WS_ACT), (const bf16*)(ws + WS_W + (size_t)l * W_LAYER + W_DN), M, DM, DFF, LDACT, 0}; pg8::StaticOrder S; S.init(M, DM, G, bx);
              pg8::EpiRes E{(bf16*)(ws + WS_HN), LDH, (pg8::ss_t*)(ws + WS_SS) + (l + 1 < DEPTH ? l + 1 : 2 * DEPTH) * M, nullptr, DM};
              pg8::gemm_phase<pg8::EpiRes, pg8::StaticOrder, true>(ldsp + RING_OFF, g, S, E); }
#if defined(PROBE_DN2)
            { ENV(); pg8::Gemm g{(const bf16*)(ws + WS_ACT), (const bf16*)(ws + WS_W + (size_t)l * W_LAYER + W_DN), M, DM, DFF, LDACT, 0}; pg8::StaticOrder S; S.init(M, DM, G, bx);
              pg8::EpiRes E{(bf16*)(ws + WS_HN), LDH, nullptr, (float*)(ws + WS_PROJ), DM};
              pg8::gemm_phase<pg8::EpiRes, pg8::StaticOrder, true, PROBE_DN2>(ldsp + RING_OFF, g, S, E); }
#endif
            SEAM(pb + 5);
        }
    }
    if (IN(N_PHASES - 1)) { ENV(); rmsnorm_final((const bf16*)(ws + WS_HN), (const pg8::ss_t*)(ws + WS_SS) + 2 * DEPTH * M, ka->out, ka->in[12], gw, ngw, lane); }
#undef IN
#undef SEAM
#undef ENV
#undef REP
}

extern "C" void kernel_launch(void* const* d_in, const int* in_sizes, int n_in, void* d_out, int out_size, void* d_ws, size_t ws_size, hipStream_t stream) {
    static int grid = 0;
    if (grid == 0) {
        if (n_in != 13 || in_sizes[0] != M * DM || out_size != M * DM || ws_size < WS_END) { fprintf(stderr, "kernel_launch: unexpected shapes / workspace (n_in %d, in0 %d, out %d, ws %zu < %zu); nothing launched\n", n_in, n_in > 0 ? in_sizes[0] : -1, out_size, ws_size, (size_t)WS_END); grid = -1; return; }
        int dev = 0, cus = 0, per_cu = 0;
        if (hipGetDevice(&dev) != hipSuccess || hipDeviceGetAttribute(&cus, hipDeviceAttributeMultiprocessorCount, dev) != hipSuccess) { fprintf(stderr, "kernel_launch: device query failed\n"); grid = -1; return; }
        if (hipFuncSetAttribute((const void*)fwd, hipFuncAttributeMaxDynamicSharedMemorySize, LDS_BYTES) != hipSuccess) { fprintf(stderr, "kernel_launch: hipFuncSetAttribute failed\n"); grid = -1; return; }
        if (hipOccupancyMaxActiveBlocksPerMultiprocessor(&per_cu, (const void*)fwd, NWAVES * 64, LDS_BYTES) != hipSuccess || per_cu < 1) fprintf(stderr, "kernel_launch: note: occupancy query reports %d workgroups per CU\n", per_cu);
        (void)hipGetLastError();
        grid = cus;
    }
    if (grid < 0) return;
    if (hipMemsetAsync((char*)d_ws + WS_CTL, 0, CTL_ZERO_BYTES, stream) != hipSuccess) { fprintf(stderr, "kernel_launch: hipMemsetAsync failed\n"); return; }
    Args a{};
    for (int i = 0; i < 13; ++i) a.in[i] = (const float*)d_in[i];
    a.out = (float*)d_out; a.ws = (unsigned char*)d_ws;
#if MK_SPLIT
    for (int p = 0; p < N_PHASES; ++p) { a.ph_lo = p; a.ph_hi = p + 1; hipLaunchKernelGGL(fwd, dim3(grid), dim3(NWAVES * 64), LDS_BYTES, stream, a); }
#else
    a.ph_lo = 0; a.ph_hi = N_PHASES; hipLaunchKernelGGL(fwd, dim3(grid), dim3(NWAVES * 64), LDS_BYTES, stream, a);
#endif
    const hipError_t le = hipPeekAtLastError();
    if (le != hipSuccess) fprintf(stderr, "kernel_launch: launch failed: %s\n", hipGetErrorName(le));
}
```
